# Optimizing an MI355X kernel written in HIP

```python
import jax, jax.numpy as jnp
from jax import lax
import numpy as np

D_MODEL = 1024
BATCH = 4
SEQ = 4096
DEPTH = 1
DEC_BATCH = 16
DEC_SEQ = 32
PAST_LEN = 4096

CHUNK = 64
N_HEADS = 16
Q_LORA = 256
KV_LORA = 128
NOPE_DIM = 64
ROPE_DIM = 32
V_DIM = 64
QK_DIM = NOPE_DIM + ROPE_DIM
ROPE_THETA = 10000.0
Q_BLOCK = 128
LRU_WIDTH = D_MODEL
LRU_BLOCKS = 8
LRU_BLOCK_W = LRU_WIDTH // LRU_BLOCKS
LRU_CONV_W = 4
RG_C = 8.0
D_FF = 2816
FFN_CONV_W = 3
EPS = 1e-6
N_IN = Q_LORA + KV_LORA + ROPE_DIM + LRU_WIDTH + 2 * D_MODEL
IN_SPLITS = (Q_LORA,
             Q_LORA + KV_LORA,
             Q_LORA + KV_LORA + ROPE_DIM,
             Q_LORA + KV_LORA + ROPE_DIM + LRU_WIDTH,
             Q_LORA + KV_LORA + ROPE_DIM + LRU_WIDTH + D_MODEL)

kernel_name = 'hybrid_mla_rglru_convffn_stream_step'


def rms_norm(x, g):
    xf = x.astype(jnp.float32)
    y = xf * lax.rsqrt(jnp.mean(xf * xf, axis=-1, keepdims=True) + EPS)
    return (y * g.astype(jnp.float32)).astype(x.dtype)


def rope_tables(pos):
    inv = ROPE_THETA ** (-jnp.arange(0, ROPE_DIM, 2, dtype=jnp.float32) / ROPE_DIM)
    ang = pos.astype(jnp.float32)[:, None] * inv[None, :]
    return jnp.cos(ang), jnp.sin(ang)


def apply_rope(x, cos, sin):
    half = x.shape[-1] // 2
    x1, x2 = x[..., :half], x[..., half:]
    c = cos.astype(x.dtype)
    s = sin.astype(x.dtype)
    return jnp.concatenate([x1 * c - x2 * s, x1 * s + x2 * c], axis=-1)


def causal_dwconv(x, buf, w, b):
    width = w.shape[0]
    t = x.shape[1]
    xc = jnp.concatenate([buf.astype(x.dtype), x], axis=1)
    y = xc[:, 0:t] * w[0]
    for j in range(1, width):
        y = y + xc[:, j:j + t] * w[j]
    return y + b, xc[:, xc.shape[1] - (width - 1):]


def chunk_causal_mla(q_nope, q_rope, k_nope, k_rope, v, q_pos, k_pos):
    b, t, h, _ = q_nope.shape
    qb = t if t <= Q_BLOCK else Q_BLOCK
    nb = t // qb
    scale = QK_DIM ** -0.5
    k_chunk = k_pos // CHUNK

    def to_blocks(a):
        return jnp.moveaxis(a.reshape((b, nb, qb) + a.shape[2:]), 1, 0)

    def one_block(args):
        qn, qr, qp = args
        s = (jnp.einsum('bqhd,bkhd->bhqk', qn, k_nope, preferred_element_type=jnp.float32)
             + jnp.einsum('bqhr,bkr->bhqk', qr, k_rope, preferred_element_type=jnp.float32))
        visible = k_chunk[None, :] <= (qp // CHUNK)[:, None]
        s = jnp.where(visible[None, None], s * scale, -jnp.inf)
        p = jax.nn.softmax(s, axis=-1).astype(v.dtype)
        return jnp.einsum('bhqk,bkhd->bqhd', p, v)

    o = lax.map(one_block, (to_blocks(q_nope), to_blocks(q_rope), q_pos.reshape(nb, qb)))
    return jnp.moveaxis(o, 0, 1).reshape(b, t, h * v.shape[-1])


def rg_lru(u, h0, w_rg, b_rg, w_ig, b_ig, lam):
    b, t, c = u.shape
    ub = u.reshape(b, t, LRU_BLOCKS, LRU_BLOCK_W)
    r = jax.nn.sigmoid(jnp.einsum('btnc,ncd->btnd', ub, w_rg).reshape(b, t, c) + b_rg)
    i = jax.nn.sigmoid(jnp.einsum('btnc,ncd->btnd', ub, w_ig).reshape(b, t, c) + b_ig)
    log_a = (-RG_C * r.astype(jnp.float32)) * jax.nn.softplus(-lam.astype(jnp.float32))
    a = jnp.exp(log_a)
    mult = jnp.sqrt(-jnp.expm1(2.0 * log_a))
    bt = mult * (i * u).astype(jnp.float32)
    bt = bt.at[:, 0].add(a[:, 0] * h0.astype(jnp.float32))

    def combine(left, right):
        a_l, b_l = left
        a_r, b_r = right
        return a_l * a_r, a_r * b_l + b_r

    _, h = lax.associative_scan(combine, (a, bt), axis=1)
    return h.astype(u.dtype), h[:, -1].astype(h0.dtype)


def hybrid_layer(x, q_pos, past_lat, past_kr, h0, lru_buf, ffn_buf,
                 g_mix_norm, w_in, g_q_a, w_q_b, g_kv_a, w_kv_b, g_qn, g_qr, g_kn, g_kr,
                 lru_conv_w, lru_conv_b, w_rg, b_rg, w_ig, b_ig, lru_lambda,
                 w_out, g_ffn_norm, w_up, ffn_conv_w, ffn_conv_b, w_down):
    b, t, _ = x.shape
    xn = rms_norm(x, g_mix_norm)
    z = xn @ w_in
    c_q, c_kv, k_r, u, gate_a, gate_b = jnp.split(z, IN_SPLITS, axis=-1)
    cos, sin = rope_tables(q_pos)
    q = (rms_norm(c_q, g_q_a) @ w_q_b).reshape(b, t, N_HEADS, QK_DIM)
    q_nope = rms_norm(q[..., :NOPE_DIM], g_qn)
    q_rope = apply_rope(rms_norm(q[..., NOPE_DIM:], g_qr), cos[:, None, :], sin[:, None, :])
    c_kv = rms_norm(c_kv, g_kv_a)
    k_r = apply_rope(rms_norm(k_r, g_kr), cos, sin)
    lat_all = jnp.concatenate([past_lat.astype(x.dtype), c_kv], axis=1)
    kr_all = jnp.concatenate([past_kr.astype(x.dtype), k_r], axis=1)
    n_k = lat_all.shape[1]
    kv = (lat_all @ w_kv_b).reshape(b, n_k, N_HEADS, NOPE_DIM + V_DIM)
    k_nope = rms_norm(kv[..., :NOPE_DIM], g_kn)
    v = kv[..., NOPE_DIM:]
    attn = chunk_causal_mla(q_nope, q_rope, k_nope, kr_all, v, q_pos,
                            jnp.arange(n_k, dtype=jnp.int32))
    u_c, lru_buf_new = causal_dwconv(u, lru_buf, lru_conv_w, lru_conv_b)
    rec, h_last = rg_lru(u_c, h0, w_rg, b_rg, w_ig, b_ig, lru_lambda)
    mixed = jax.nn.sigmoid(gate_a) * attn + jax.nn.sigmoid(gate_b) * rec
    x = x + mixed @ w_out
    up = rms_norm(x, g_ffn_norm) @ w_up
    up_c, ffn_buf_new = causal_dwconv(up, ffn_buf, ffn_conv_w, ffn_conv_b)
    gate, val = jnp.split(up_c, 2, axis=-1)
    x = x + (jax.nn.silu(gate) * val) @ w_down
    return x, (c_kv, k_r, h_last, lru_buf_new, ffn_buf_new)


def setup_inputs(seed: int = 0) -> dict:
    key = jax.random.key(seed)
    ks = jax.random.split(key, 40)
    f32 = jnp.float32

    def nrm(k, shape, scale):
        return jax.random.normal(k, shape, f32) * scale

    def gain(k, shape):
        return 1.0 + 0.01 * jax.random.normal(k, shape, f32)

    a0 = jax.random.uniform(ks[29], (DEPTH, LRU_WIDTH), f32, minval=0.9, maxval=0.999)
    return {
        'x_prompt': nrm(ks[0], (BATCH, SEQ, D_MODEL), 1.0),
        'x_sample': nrm(ks[1], (DEC_BATCH, DEC_SEQ, D_MODEL), 1.0),
        'cache_kv_latent': nrm(ks[2], (DEPTH, DEC_BATCH, PAST_LEN, KV_LORA), 1.0),
        'cache_k_rope': nrm(ks[3], (DEPTH, DEC_BATCH, PAST_LEN, ROPE_DIM), 1.0),
        'state_lru_h': nrm(ks[4], (DEPTH, DEC_BATCH, LRU_WIDTH), 0.5),
        'state_lru_conv': nrm(ks[5], (DEPTH, DEC_BATCH, LRU_CONV_W - 1, LRU_WIDTH), 1.0),
        'state_ffn_conv': nrm(ks[6], (DEPTH, DEC_BATCH, FFN_CONV_W - 1, 2 * D_FF), 1.0),
        'g_mix_norm': gain(ks[7], (DEPTH, D_MODEL)),
        'w_in': nrm(ks[8], (DEPTH, D_MODEL, N_IN), D_MODEL ** -0.5),
        'g_q_a': gain(ks[9], (DEPTH, Q_LORA)),
        'w_q_b': nrm(ks[10], (DEPTH, Q_LORA, N_HEADS * QK_DIM), Q_LORA ** -0.5),
        'g_kv_a': gain(ks[11], (DEPTH, KV_LORA)),
        'w_kv_b': nrm(ks[12], (DEPTH, KV_LORA, N_HEADS * (NOPE_DIM + V_DIM)), KV_LORA ** -0.5),
        'g_qn': gain(ks[13], (DEPTH, NOPE_DIM)),
        'g_qr': gain(ks[14], (DEPTH, ROPE_DIM)),
        'g_kn': gain(ks[15], (DEPTH, NOPE_DIM)),
        'g_kr': gain(ks[16], (DEPTH, ROPE_DIM)),
        'lru_conv_w': nrm(ks[17], (DEPTH, LRU_CONV_W, LRU_WIDTH), LRU_CONV_W ** -0.5),
        'lru_conv_b': nrm(ks[18], (DEPTH, LRU_WIDTH), 0.01),
        'w_rg': nrm(ks[19], (DEPTH, LRU_BLOCKS, LRU_BLOCK_W, LRU_BLOCK_W), LRU_BLOCK_W ** -0.5),
        'b_rg': nrm(ks[20], (DEPTH, LRU_WIDTH), 0.01),
        'w_ig': nrm(ks[21], (DEPTH, LRU_BLOCKS, LRU_BLOCK_W, LRU_BLOCK_W), LRU_BLOCK_W ** -0.5),
        'b_ig': nrm(ks[22], (DEPTH, LRU_WIDTH), 0.01),
        'lru_lambda': jnp.log(a0) - jnp.log1p(-a0),
        'w_out': nrm(ks[23], (DEPTH, D_MODEL, D_MODEL), D_MODEL ** -0.5),
        'g_ffn_norm': gain(ks[24], (DEPTH, D_MODEL)),
        'w_up': nrm(ks[25], (DEPTH, D_MODEL, 2 * D_FF), D_MODEL ** -0.5),
        'ffn_conv_w': nrm(ks[26], (DEPTH, FFN_CONV_W, 2 * D_FF), FFN_CONV_W ** -0.5),
        'ffn_conv_b': nrm(ks[27], (DEPTH, 2 * D_FF), 0.01),
        'w_down': nrm(ks[28], (DEPTH, D_FF, D_MODEL), D_FF ** -0.5),
    }


def reference(x_prompt, x_sample, cache_kv_latent, cache_k_rope, state_lru_h, state_lru_conv,
              state_ffn_conv, g_mix_norm, w_in, g_q_a, w_q_b, g_kv_a, w_kv_b, g_qn, g_qr, g_kn, g_kr,
              lru_conv_w, lru_conv_b, w_rg, b_rg, w_ig, b_ig, lru_lambda, w_out, g_ffn_norm,
              w_up, ffn_conv_w, ffn_conv_b, w_down):
    bp, tp = x_prompt.shape[0], x_prompt.shape[1]
    ts = x_sample.shape[1]
    past = cache_kv_latent.shape[2]
    dt = x_prompt.dtype
    pos_p = jnp.arange(tp, dtype=jnp.int32)
    pos_s = past + jnp.arange(ts, dtype=jnp.int32)
    yp, ys = x_prompt, x_sample
    p_states = [[], [], [], [], []]
    s_states = [[], [], [], [], []]
    for l in range(DEPTH):
        lp = (g_mix_norm[l], w_in[l], g_q_a[l], w_q_b[l], g_kv_a[l], w_kv_b[l], g_qn[l], g_qr[l],
              g_kn[l], g_kr[l], lru_conv_w[l], lru_conv_b[l], w_rg[l], b_rg[l], w_ig[l], b_ig[l],
              lru_lambda[l], w_out[l], g_ffn_norm[l], w_up[l], ffn_conv_w[l], ffn_conv_b[l], w_down[l])
        yp, st_p = hybrid_layer(yp, pos_p,
                                jnp.zeros((bp, 0, KV_LORA), dt), jnp.zeros((bp, 0, ROPE_DIM), dt),
                                jnp.zeros((bp, LRU_WIDTH), dt),
                                jnp.zeros((bp, LRU_CONV_W - 1, LRU_WIDTH), dt),
                                jnp.zeros((bp, FFN_CONV_W - 1, 2 * D_FF), dt), *lp)
        ys, st_s = hybrid_layer(ys, pos_s, cache_kv_latent[l], cache_k_rope[l], state_lru_h[l],
                                state_lru_conv[l], state_ffn_conv[l], *lp)
        for j in range(5):
            p_states[j].append(st_p[j])
            s_states[j].append(st_s[j])
    p_lat, p_kr, p_h, p_conv, p_ffn = [jnp.stack(s, axis=0) for s in p_states]
    s_lat, s_kr, s_h, s_conv, s_ffn = [jnp.stack(s, axis=0) for s in s_states]
    return (yp, ys, p_lat, p_kr, p_h, p_conv, p_ffn, s_lat, s_kr, s_h, s_conv, s_ffn)
```

```cpp
#include <hip/hip_runtime.h>
#include <cstdio>
#include <cstdint>

#ifndef MK_LAUNCHES
#define MK_LAUNCHES 1
#endif

#define LAS __attribute__((address_space(3)))
#define DI __device__ __forceinline__
typedef unsigned short bf16_t;
typedef short bf16x8 __attribute__((ext_vector_type(8)));
typedef short s16x4 __attribute__((ext_vector_type(4)));
typedef float f32x4 __attribute__((ext_vector_type(4)));
typedef float f32x2 __attribute__((ext_vector_type(2)));
typedef float f32x16 __attribute__((ext_vector_type(16)));
typedef unsigned u32x4 __attribute__((ext_vector_type(4)));
typedef unsigned u32x2 __attribute__((ext_vector_type(2)));
typedef __bf16 bf16x2_t __attribute__((ext_vector_type(2)));

constexpr int DM = 1024, PB = 4, PT = 4096, SB = 16, ST = 32, PAST = 4096;
constexpr int MP = PB * PT, MS = SB * ST, MT = MP + MS;
constexpr int NH = 16, QL = 256, KVL = 128, NOPE = 64, ROPE = 32, QKD = 96;
constexpr int DFF = 2816, NUP = 2 * DFF;
constexpr int SKEYS = PAST + ST;
constexpr int LROWS = MP + SB * SKEYS;
constexpr float EPS = 1e-6f;
constexpr float LOG2E = 1.4426950408889634f;
constexpr float QSCALE = 0.10206207261596577f * LOG2E;
constexpr int ZQW = 416;

constexpr size_t MiB = 1u << 20;
constexpr size_t WS_CTL = 0, CTL_BYTES = 64 * 1024;
constexpr size_t WS_TAB = 1 * MiB;
constexpr size_t WS_SP8 = 1 * MiB + 768 * 1024;
constexpr size_t WS_SSCQ = 1 * MiB + 896 * 1024;
constexpr size_t WS_SSROW = 2 * MiB;
constexpr size_t WS_CWS = 3 * MiB;
constexpr size_t WS_AGG = 4 * MiB;
constexpr size_t WS_WIN = 6 * MiB;
constexpr size_t WS_WQB = 13 * MiB;
constexpr size_t WS_WKVB = 13 * MiB + 768 * 1024;
constexpr size_t WS_WKVN = 14 * MiB + 256 * 1024;
constexpr size_t WS_WLRU = 14 * MiB + 768 * 1024;
constexpr size_t WS_WOUT = 15 * MiB + 512 * 1024;
constexpr size_t WS_WUP = 17 * MiB + 512 * 1024;
constexpr size_t WS_WDOWN = 28 * MiB + 512 * 1024;
constexpr size_t WS_LAT = 34 * MiB;
constexpr size_t WS_KR = 54 * MiB + 512 * 1024;
constexpr size_t WS_GATES = 60 * MiB;
constexpr size_t WS_XN = 126 * MiB;
constexpr size_t WS_ZQ = 159 * MiB;
constexpr size_t WS_CQN = 228 * MiB;
constexpr size_t WS_UC = 126 * MiB;
constexpr size_t WS_LA = 159 * MiB;
constexpr size_t WS_BT = 192 * MiB;
constexpr size_t WS_Q1 = 126 * MiB;
constexpr size_t WS_Q2 = 237 * MiB;
constexpr int QSPLIT = 11264;
constexpr size_t WS_MIX = 192 * MiB;
constexpr size_t WS_XMB = 126 * MiB;
constexpr size_t WS_HFF = 160 * MiB;
constexpr size_t WS_END = 254 * MiB;
constexpr int XMB_ROWS = 17152;

constexpr size_t O_Y = 0;
constexpr size_t O_PLAT = (size_t)MT * DM;
constexpr size_t O_PKR = O_PLAT + (size_t)MP * KVL;
constexpr size_t O_PH = O_PKR + (size_t)MP * ROPE;
constexpr size_t O_PCONV = O_PH + (size_t)PB * DM;
constexpr size_t O_PFFN = O_PCONV + (size_t)PB * 3 * DM;
constexpr size_t O_SLAT = O_PFFN + (size_t)PB * 2 * NUP;
constexpr size_t O_SKR = O_SLAT + (size_t)MS * KVL;
constexpr size_t O_SH = O_SKR + (size_t)MS * ROPE;
constexpr size_t O_SCONV = O_SH + (size_t)SB * DM;
constexpr size_t O_SFFN = O_SCONV + (size_t)SB * 3 * DM;
constexpr size_t O_END = O_SFFN + (size_t)SB * 2 * NUP;
static_assert(O_END == 20312064, "output size");

DI unsigned cvtpk(float lo, float hi) { f32x2 v = {lo, hi}; bf16x2_t b = __builtin_convertvector(v, bf16x2_t); return __builtin_bit_cast(unsigned, b); }
DI float bf2f(unsigned short b) { return __uint_as_float((unsigned)b << 16); }
DI float bflo(unsigned w) { return __uint_as_float(w << 16); }
DI float bfhi(unsigned w) { return __uint_as_float(w & 0xffff0000u); }
DI float wave_sum(float v) {
#pragma unroll
    for (int o = 1; o < 64; o <<= 1) v += __shfl_xor(v, o);
    return v;
}
DI int fresh_lane() { int l; asm volatile("v_mbcnt_lo_u32_b32 %0, -1, 0\n\tv_mbcnt_hi_u32_b32 %0, -1, %0" : "=v"(l)); return l; }
DI float bperm(int byteaddr, float v) { return __int_as_float(__builtin_amdgcn_ds_bpermute(byteaddr, __float_as_int(v))); }
template <int CTRL> DI float dpp_mov(float v) { return __int_as_float(__builtin_amdgcn_update_dpp(0, __float_as_int(v), CTRL, 0xf, 0xf, false)); }
DI float sigmoidf_(float x) { return __builtin_amdgcn_rcpf(1.0f + __expf(-x)); }
DI float xsum32(float x) { const auto r = __builtin_amdgcn_permlane32_swap(__float_as_uint(x), __float_as_uint(x), false, false); return __uint_as_float(r[0]) + __uint_as_float(r[1]); }
DI float xsum16(float x) { const auto r = __builtin_amdgcn_permlane16_swap(__float_as_uint(x), __float_as_uint(x), false, false); return __uint_as_float(r[0]) + __uint_as_float(r[1]); }
DI float rowsum4(float x) { return xsum32(xsum16(x)); }
#define SG2(x) __builtin_amdgcn_rcpf(1.0f + __builtin_amdgcn_exp2f(x))
DI bf16_t* q_part(unsigned char* ws, size_t row) { return row < (size_t)QSPLIT ? (bf16_t*)(ws + WS_Q1) : (bf16_t*)(ws + WS_Q2) - (size_t)QSPLIT * 1536; }
DI int row_pos(int m) { return m < MP ? (m & (PT - 1)) : PAST + ((m - MP) & (ST - 1)); }
DI int lat_row(int m) { if (m < MP) return m; const int ms = m - MP; return MP + (ms >> 5) * SKEYS + PAST + (ms & 31); }
#define LDS_WAIT() asm volatile("s_waitcnt lgkmcnt(0)" ::: "memory")
DI int crow(int r, int hi) { return (r & 3) + 8 * (r >> 2) + 4 * hi; }
#define MFMA32(a, b, c) __builtin_amdgcn_mfma_f32_32x32x16_bf16((a), (b), (c), 0, 0, 0)

namespace pg8 {
constexpr int BM = 256, BK = 64, HALF = 128, HTB = HALF * BK * 2, STAGE_BYTES = 8 * HTB, NXCD = 8, WGM = 8;
__host__ __device__ __forceinline__ int lds_byte(int r, int c) { const int st = (r >> 4) * 2 + (c >> 5), rr = r & 15, cc = c & 31, ob = rr * 64 + cc * 2; return st * 1024 + (ob ^ (((ob >> 9) & 1) << 5)); }
__host__ __device__ __forceinline__ void stage_rc(int b, int& R, int& C) { const int st = b / 1024, sb = b % 1024, swz = sb ^ (((sb >> 9) & 1) << 5); R = (st >> 1) * 16 + swz / 64; C = (st & 1) * 32 + (swz % 64) / 2; }

struct Unit { int pm, pn; };
struct Gemm { const bf16_t* A; const bf16_t* Bt; int lda, ldb, K, acoln, ks, kcol, nM, nN; };

struct StaticOrder {
    int nM, nN, nwg, G, c;
    DI void init(int nM_, int nN_, int G_, int c_) { nM = nM_; nN = nN_; nwg = nM * nN; G = G_; c = c_; }
    DI bool next(int i, Unit& u) const {
        const long L = (long)i * G + c; if (L >= nwg) return false;
        int wgid = (int)L; { const int q = nwg / NXCD, r = nwg % NXCD, xcd = wgid % NXCD, off = wgid / NXCD; wgid = (xcd < r ? xcd * (q + 1) : r * (q + 1) + (xcd - r) * q) + off; }
        const int nig = WGM * nN, gid = wgid / nig, fm = gid * WGM, gsz = (nM - fm) < WGM ? (nM - fm) : WGM;
        u.pm = fm + ((wgid % nig) % gsz); u.pn = (wgid % nig) / gsz; return true;
    }
};

template <class Epi> struct RowPerm { static constexpr bool v = false; };
template <int OV, class Epi>
DI void gemm_phase(LAS unsigned char* lds, const int wid, const Gemm g, const StaticOrder& S, const Epi& E) {
    const int wr = wid >> 2, wc = wid & 3;
    int K = g.K; asm volatile("" : "+s"(K));
    const int nt = K / BK;
    unsigned voffA[2], voffB[2]; int aoff, boff;
#define PG8_LANE_STATE() do { const int lane_ = fresh_lane(), tid_ = wid * 64 + lane_, fr_ = lane_ & 15, fq_ = lane_ >> 4; \
        _Pragma("unroll") for (int i = 0; i < 2; ++i) { int R, C; stage_rc(tid_ * 16 + i * 8192, R, C); \
            const int Ra_ = RowPerm<Epi>::v ? ((R & ~63) | (4 * (R & 15) + ((R >> 4) & 3))) : R; \
            voffA[i] = (unsigned)((Ra_ - OV * (Ra_ >> 6)) * g.lda + C) * 2u; voffB[i] = (unsigned)(R * g.ldb + C) * 2u; } \
        aoff = lds_byte(wr * 64 + fr_, fq_ * 8); boff = lds_byte(wc * 32 + fr_, fq_ * 8); } while (0)
    PG8_LANE_STATE();
    const size_t kstep = (size_t)(BK * 2);
    const size_t hstepA = (size_t)(HALF - 2 * OV) * g.lda * 2, hstepB = (size_t)HALF * g.ldb * 2;
    const size_t tstepA = 2 * hstepA, tstepB = 2 * hstepB;
    const unsigned ldsw = (unsigned)wid * 1024u;
#define PG8_SA(b, h) (((b) * 2 + (h)) * HTB)
#define PG8_SB(b, h) ((4 + (b) * 2 + (h)) * HTB)
#define PG8_STAGE(bufoff, gbase, voff) do { _Pragma("unroll") for (int _i = 0; _i < 2; ++_i) \
        __builtin_amdgcn_global_load_lds((const unsigned*)((const char*)(gbase) + (voff)[_i]), (LAS unsigned*)(lds + (bufoff) + ldsw + _i * 8192), 16, 0, 0); } while (0)
#define PG8_LDA(dst, b, h) do { _Pragma("unroll") for (int m = 0; m < 4; ++m) _Pragma("unroll") for (int k = 0; k < 2; ++k) dst[m][k] = *(const LAS bf16x8*)(lds + PG8_SA(b, h) + aoff + m * 2048 + k * 1024); } while (0)
#define PG8_LDB(dst, b, h) do { _Pragma("unroll") for (int n = 0; n < 2; ++n) _Pragma("unroll") for (int k = 0; k < 2; ++k) dst[n][k] = *(const LAS bf16x8*)(lds + PG8_SB(b, h) + boff + n * 2048 + k * 1024); } while (0)
#define PG8_MMA(ai, bj, At, Bt) do { __builtin_amdgcn_s_setprio(1); _Pragma("unroll") for (int m = 0; m < 4; ++m) _Pragma("unroll") for (int n = 0; n < 2; ++n) _Pragma("unroll") for (int k = 0; k < 2; ++k) \
        acc[ai][bj][m][n] = __builtin_amdgcn_mfma_f32_16x16x32_bf16(Bt[n][k], At[m][k], acc[ai][bj][m][n], 0, 0, 0); __builtin_amdgcn_s_setprio(0); } while (0)
#define PG8_WAIT_V(n) asm volatile("s_waitcnt vmcnt(" #n ")" ::: "memory")
#define PG8_WAIT_L(n) asm volatile("s_waitcnt lgkmcnt(" #n ")" ::: "memory")
#define PG8_BAR __builtin_amdgcn_s_barrier()
#define PG8_SCHED __builtin_amdgcn_sched_barrier(0)
#define PG8_ABASE(u) ((const char*)g.A + ((long)Epi::rowtile((u).pm) * (BM - 4 * OV) - OV) * (long)g.lda * 2 + (long)(((u).pn / g.ks) * g.acoln + ((u).pn % g.ks) * g.kcol) * 2)
#define PG8_BBASE(u) ((const char*)g.Bt + (size_t)((u).pn / g.ks) * tstepB + (size_t)(((u).pn % g.ks) * g.kcol) * 2)
    Unit cur, nxt; int ui = 0;
    if (!S.next(0, cur)) return;
    E.prefetch(lds, wid, Epi::rowtile(cur.pm), cur.pn / g.ks, 0);
    f32x4 acc[2][2][4][2];
#pragma unroll
    for (int a = 0; a < 2; ++a)
#pragma unroll
        for (int b = 0; b < 2; ++b)
#pragma unroll
            for (int m = 0; m < 4; ++m)
#pragma unroll
                for (int n = 0; n < 2; ++n) acc[a][b][m][n] = (f32x4){0.f, 0.f, 0.f, 0.f};
    bf16x8 At[4][2], B0[2][2], B1[2][2];
    const char* cA = PG8_ABASE(cur); const char* cB = PG8_BBASE(cur);
    PG8_STAGE(PG8_SB(0, 0), cB, voffB); PG8_STAGE(PG8_SB(0, 1), cB + hstepB, voffB); PG8_STAGE(PG8_SA(0, 0), cA, voffA); PG8_STAGE(PG8_SA(0, 1), cA + hstepA, voffA);
    if (wr == 1) PG8_BAR;
    PG8_WAIT_V(2); PG8_BAR;
    PG8_STAGE(PG8_SB(1, 0), cB + kstep, voffB); PG8_STAGE(PG8_SA(1, 0), cA + kstep, voffA); PG8_STAGE(PG8_SB(1, 1), cB + hstepB + kstep, voffB);
    PG8_WAIT_V(6); PG8_BAR;
    for (;;) {
        const bool has_next = S.next(ui + 1, nxt);
        const char* nA = has_next ? PG8_ABASE(nxt) : cA; const char* nB = has_next ? PG8_BBASE(nxt) : cB;
        for (int t = 0; t < nt; t += 2) {
            const bool last = (t == nt - 2);
            const char* a1 = cA + (size_t)(t + 1) * kstep;
            const char* a2 = last ? nA : cA + (size_t)(t + 2) * kstep; const char* b2 = last ? nB : cB + (size_t)(t + 2) * kstep;
            const char* a3 = a2 + kstep; const char* b3 = b2 + kstep;
            PG8_LDB(B0, 0, 0); PG8_LDB(B1, 0, 1); PG8_SCHED; PG8_LDA(At, 0, 0); PG8_STAGE(PG8_SA(1, 1), a1 + hstepA, voffA);
            PG8_WAIT_V(8); PG8_WAIT_L(0); PG8_BAR; PG8_MMA(0, 0, At, B0); PG8_MMA(0, 1, At, B1); PG8_BAR; PG8_SCHED;
            PG8_LDA(At, 0, 1); PG8_STAGE(PG8_SB(0, 0), b2, voffB); PG8_STAGE(PG8_SB(0, 1), b2 + hstepB, voffB); PG8_STAGE(PG8_SA(0, 0), a2, voffA);
            PG8_WAIT_V(8); PG8_WAIT_L(0); PG8_BAR; PG8_MMA(1, 0, At, B0); PG8_MMA(1, 1, At, B1); PG8_BAR; PG8_SCHED;
            PG8_LDB(B0, 1, 0); PG8_LDB(B1, 1, 1); PG8_SCHED; PG8_LDA(At, 1, 0); PG8_STAGE(PG8_SA(0, 1), a2 + hstepA, voffA);
            PG8_WAIT_V(8); PG8_WAIT_L(0); PG8_BAR; PG8_MMA(0, 0, At, B0); PG8_MMA(0, 1, At, B1); PG8_BAR; PG8_SCHED;
            PG8_LDA(At, 1, 1); PG8_STAGE(PG8_SB(1, 0), b3, voffB); PG8_STAGE(PG8_SB(1, 1), b3 + hstepB, voffB); PG8_STAGE(PG8_SA(1, 0), a3, voffA);
            PG8_WAIT_V(8); PG8_WAIT_L(0); PG8_BAR; PG8_MMA(1, 0, At, B0); PG8_MMA(1, 1, At, B1); PG8_BAR; PG8_SCHED;
        }
        if (wr == 0) PG8_BAR;
        E(acc, Epi::rowtile(cur.pm), cur.pn / g.ks, wr, wc, 0, 0, lds, ui & 1);
        if (!has_next) break;
        PG8_LANE_STATE();
#pragma unroll
        for (int a = 0; a < 2; ++a)
#pragma unroll
            for (int b = 0; b < 2; ++b)
#pragma unroll
                for (int m = 0; m < 4; ++m)
#pragma unroll
                    for (int n = 0; n < 2; ++n) acc[a][b][m][n] = (f32x4){0.f, 0.f, 0.f, 0.f};
        cur = nxt; cA = nA; cB = nB; ++ui;
        E.prefetch(lds, wid, Epi::rowtile(cur.pm), cur.pn / g.ks, ui & 1);
        if (wr == 1) PG8_BAR;
    }
    PG8_WAIT_V(0);
    PG8_BAR;
#undef PG8_SA
#undef PG8_SB
#undef PG8_STAGE
#undef PG8_LDA
#undef PG8_LDB
#undef PG8_MMA
#undef PG8_WAIT_V
#undef PG8_WAIT_L
#undef PG8_BAR
#undef PG8_SCHED
#undef PG8_LANE_STATE
#undef PG8_ABASE
#undef PG8_BBASE
}
}

typedef f32x4 AccT[2][2][4][2];
#define EPI_FENCE() do { asm volatile("" ::: "memory"); __builtin_amdgcn_sched_barrier(0); } while (0)

struct EpiIn {
    bf16_t* cq; float* sscq; bf16_t* u; bf16_t* gates;
    const float* g_kv; const float* g_kr; const f32x2* tab; float* out; bf16_t* lat; bf16_t* krb;
    static DI int rowtile(int pm) { return pm; }
    DI void prefetch(LAS unsigned char*, int, int, int, int) const {}
    DI void operator()(const AccT& acc, int pm, int pn, int wr, int wc, int fr, int fq, LAS unsigned char* lds, int slot) const {
        { const int l_ = fresh_lane(); fr = l_ & 15; fq = l_ >> 4; }
        const int row0 = pm * 256 + wr * 64 + fr, cl = wc * 32 + 4 * fq;
        if (pn == 0) {
#pragma unroll
            for (int ai = 0; ai < 2; ++ai)
#pragma unroll
                for (int m = 0; m < 4; ++m) { const size_t row = (size_t)(row0 + ai * 128 + m * 16); float ss = 0.f;
#pragma unroll
                    for (int bj = 0; bj < 2; ++bj)
#pragma unroll
                        for (int n = 0; n < 2; ++n) { const int c = cl + 128 * bj + 16 * n; const f32x4 v = acc[ai][bj][m][n];
                            u32x2 w; w.x = cvtpk(v[0], v[1]); w.y = cvtpk(v[2], v[3]); *(u32x2*)(cq + row * QL + c) = w;
                            ss += (v[0] * v[0] + v[1] * v[1]) + (v[2] * v[2] + v[3] * v[3]); }
                    ss = rowsum4(ss);
                    if (fq == 0) (void)__hip_atomic_fetch_add(sscq + row, ss, __ATOMIC_RELAXED, __HIP_MEMORY_SCOPE_AGENT); }
        } else if (pn == 1) {
            LAS float* X = (LAS float*)(lds + 131072 + 1024);
#pragma unroll
            for (int ai = 0; ai < 2; ++ai)
#pragma unroll
                for (int m = 0; m < 4; ++m) { const f32x4 a = acc[ai][0][m][0], b = acc[ai][0][m][1];
                    float ss = (a[0] * a[0] + a[1] * a[1]) + (a[2] * a[2] + a[3] * a[3]) + (b[0] * b[0] + b[1] * b[1]) + (b[2] * b[2] + b[3] * b[3]);
                    ss = rowsum4(ss);
                    if (fq == 0) X[(ai * 128 + wr * 64 + m * 16 + fr) * 4 + wc] = ss; }
            asm volatile("s_waitcnt lgkmcnt(0)" ::: "memory"); __builtin_amdgcn_s_barrier(); asm volatile("" ::: "memory");
            f32x4 gkv[2];
#pragma unroll
            for (int n = 0; n < 2; ++n) gkv[n] = *(const f32x4*)(g_kv + cl + 16 * n);
#pragma unroll
            for (int ai = 0; ai < 2; ++ai)
#pragma unroll
                for (int m = 0; m < 4; ++m) { const int rt = ai * 128 + wr * 64 + m * 16 + fr, rowi = pm * 256 + rt; const size_t row = (size_t)rowi;
                    const f32x4 ps = *(const LAS f32x4*)(X + rt * 4);
                    const float rkv = rsqrtf(((ps[0] + ps[1]) + (ps[2] + ps[3])) * (1.0f / KVL) + EPS);
                    const size_t lrow = (size_t)lat_row(rowi);
                    float* ol = rowi < MP ? out + O_PLAT + row * KVL : out + O_SLAT + (size_t)(rowi - MP) * KVL;
#pragma unroll
                    for (int n = 0; n < 2; ++n) { const int c = cl + 16 * n; const f32x4 lt = acc[ai][0][m][n] * gkv[n] * rkv;
                        *(f32x4*)(ol + c) = lt; u32x2 w; w.x = cvtpk(lt[0], lt[1]); w.y = cvtpk(lt[2], lt[3]); *(u32x2*)(lat + lrow * KVL + c) = w; }
                    if (wc == 0) {
                        const f32x4 a = acc[ai][1][m][0], b = acc[ai][1][m][1];
                        float ss = (a[0] * a[0] + a[1] * a[1]) + (a[2] * a[2] + a[3] * a[3]) + (b[0] * b[0] + b[1] * b[1]) + (b[2] * b[2] + b[3] * b[3]);
                        ss = rowsum4(ss);
                        const float rk = rsqrtf(ss * (1.0f / ROPE) + EPS);
                        const f32x4 g1 = *(const f32x4*)(g_kr + 4 * fq), g2 = *(const f32x4*)(g_kr + 16 + 4 * fq);
                        const f32x2* tp = tab + (size_t)row_pos(rowi) * 16 + 4 * fq;
                        const f32x4 cs01 = *(const f32x4*)tp, cs23 = *(const f32x4*)(tp + 2);
                        const float cc[4] = {cs01[0], cs01[2], cs23[0], cs23[2]}, sn[4] = {cs01[1], cs01[3], cs23[1], cs23[3]};
                        f32x4 o1, o2;
#pragma unroll
                        for (int i = 0; i < 4; ++i) { const float x1 = a[i] * g1[i] * rk, x2 = b[i] * g2[i] * rk; o1[i] = x1 * cc[i] - x2 * sn[i]; o2[i] = x1 * sn[i] + x2 * cc[i]; }
                        float* ok = rowi < MP ? out + O_PKR + row * ROPE : out + O_SKR + (size_t)(rowi - MP) * ROPE;
                        *(f32x4*)(ok + 4 * fq) = o1; *(f32x4*)(ok + 16 + 4 * fq) = o2;
                        u32x2 w; w.x = cvtpk(o1[0], o1[1]); w.y = cvtpk(o1[2], o1[3]); *(u32x2*)(krb + lrow * ROPE + 4 * fq) = w;
                        w.x = cvtpk(o2[0], o2[1]); w.y = cvtpk(o2[2], o2[3]); *(u32x2*)(krb + lrow * ROPE + 16 + 4 * fq) = w; }
                    EPI_FENCE(); }
        } else {
#pragma unroll
            for (int ai = 0; ai < 2; ++ai)
#pragma unroll
                for (int m = 0; m < 4; ++m) { const size_t row = (size_t)(row0 + ai * 128 + m * 16);
#pragma unroll
                    for (int bj = 0; bj < 2; ++bj) { const int c = wc * 32 + 8 * fq + 128 * bj; const f32x4 v = acc[ai][bj][m][0], v2 = acc[ai][bj][m][1];
                            u32x4 w;
                            if (pn < 6) { w.x = cvtpk(v[0], v[1]); w.y = cvtpk(v[2], v[3]); w.z = cvtpk(v2[0], v2[1]); w.w = cvtpk(v2[2], v2[3]); *(u32x4*)(u + row * DM + (pn - 2) * 256 + c) = w; }
                            else { w.x = cvtpk(SG2(v[0]), SG2(v[1])); w.y = cvtpk(SG2(v[2]), SG2(v[3])); w.z = cvtpk(SG2(v2[0]), SG2(v2[1])); w.w = cvtpk(SG2(v2[2]), SG2(v2[3]));
                                *(u32x4*)(gates + row * 2048 + (pn - 6) * 256 + c) = w; } } }
        }
    }
};

struct EpiLru {
    const bf16_t* uc; const float* b_rg; const float* b_ig; const float* sp8; bf16_t* la; bf16_t* bt;
    static DI int rowtile(int pm) { return pm; }
    DI void prefetch(LAS unsigned char*, int, int, int, int) const {}
    DI void operator()(const AccT& acc, int pm, int pn, int wr, int wc, int fr, int fq, LAS unsigned char* lds, int slot) const {
        { const int l_ = fresh_lane(); fr = l_ & 15; fq = l_ >> 4; }
        const int row0 = pm * 256 + wr * 64 + fr, ch = pn * 128 + wc * 32 + 8 * fq;
        float nbr[8], nbi[8], spa[8], spb[8];
#pragma unroll
        for (int h = 0; h < 2; ++h) { const f32x4 brg = *(const f32x4*)(b_rg + ch + 4 * h), big = *(const f32x4*)(b_ig + ch + 4 * h), sp = *(const f32x4*)(sp8 + ch + 4 * h);
#pragma unroll
            for (int i = 0; i < 4; ++i) { nbr[4 * h + i] = -LOG2E * brg[i]; nbi[4 * h + i] = -LOG2E * big[i]; spa[4 * h + i] = sp[i] * LOG2E; spb[4 * h + i] = sp[i] * (2.0f * LOG2E); } }
#pragma unroll
        for (int ai = 0; ai < 2; ++ai) {
            u32x4 uw[4];
#pragma unroll
            for (int m = 0; m < 4; ++m) uw[m] = *(const u32x4*)(uc + (size_t)(row0 + ai * 128 + m * 16) * DM + ch);
#pragma unroll
            for (int m = 0; m < 4; ++m) { const size_t row = (size_t)(row0 + ai * 128 + m * 16);
                const float uv[8] = {bflo(uw[m].x), bfhi(uw[m].x), bflo(uw[m].y), bfhi(uw[m].y), bflo(uw[m].z), bfhi(uw[m].z), bflo(uw[m].w), bfhi(uw[m].w)};
                float lo[8], bo[8];
#pragma unroll
                for (int n = 0; n < 2; ++n)
#pragma unroll
                    for (int i = 0; i < 4; ++i) { const int k = 4 * n + i;
                        const float r = __builtin_amdgcn_rcpf(1.0f + __builtin_amdgcn_exp2f(acc[ai][0][m][n][i] * -LOG2E + nbr[k]));
                        const float ig = __builtin_amdgcn_rcpf(1.0f + __builtin_amdgcn_exp2f(acc[ai][1][m][n][i] * -LOG2E + nbi[k]));
                        const float m2 = 1.0f - __builtin_amdgcn_exp2f(r * spb[k]);
                        lo[k] = r * spa[k]; bo[k] = __builtin_amdgcn_sqrtf(m2) * ig * uv[k]; }
                u32x4 w; w.x = cvtpk(lo[0], lo[1]); w.y = cvtpk(lo[2], lo[3]); w.z = cvtpk(lo[4], lo[5]); w.w = cvtpk(lo[6], lo[7]); *(u32x4*)(la + row * DM + ch) = w;
                w.x = cvtpk(bo[0], bo[1]); w.y = cvtpk(bo[2], bo[3]); w.z = cvtpk(bo[4], bo[5]); w.w = cvtpk(bo[6], bo[7]); *(u32x4*)(bt + row * DM + ch) = w; }
            EPI_FENCE(); }
    }
};

struct EpiQ {
    unsigned char* wsq; const float* g_qn; const float* g_qr; const f32x2* tab; const float* sscq;
    static DI int rowtile(int pm) { return pm; }
    DI void prefetch(LAS unsigned char*, int, int, int, int) const {}
    DI void operator()(const AccT& acc, int pm, int pn, int wr, int wc, int fr, int fq, LAS unsigned char* lds, int slot) const {
        { const int l_ = fresh_lane(); fr = l_ & 15; fq = l_ >> 4; }
        const int row0 = pm * 256 + wr * 64 + fr;
        bf16_t* q = q_part(wsq, (size_t)pm * 256);
        float rqv[2][4];
#pragma unroll
        for (int ai = 0; ai < 2; ++ai)
#pragma unroll
            for (int m = 0; m < 4; ++m) rqv[ai][m] = rsqrtf(sscq[row0 + ai * 128 + m * 16] * (1.0f / QL) + EPS);
        if (pn < 4) {
            const int head = 4 * pn + wc;
            f32x4 gq[2][2];
#pragma unroll
            for (int bj = 0; bj < 2; ++bj)
#pragma unroll
                for (int n = 0; n < 2; ++n) gq[bj][n] = *(const f32x4*)(g_qn + 32 * bj + 8 * fq + 4 * n);
#pragma unroll
            for (int ai = 0; ai < 2; ++ai)
#pragma unroll
                for (int m = 0; m < 4; ++m) { const size_t row = (size_t)(row0 + ai * 128 + m * 16);
                    float ss = 0.f;
#pragma unroll
                    for (int bj = 0; bj < 2; ++bj)
#pragma unroll
                        for (int n = 0; n < 2; ++n) { const f32x4 v = acc[ai][bj][m][n]; ss += (v[0] * v[0] + v[1] * v[1]) + (v[2] * v[2] + v[3] * v[3]); }
                    ss = rowsum4(ss);
                    const float rq = rqv[ai][m], r = rsqrtf(rq * rq * ss * (1.0f / 64.0f) + EPS) * rq * QSCALE;
#pragma unroll
                    for (int bj = 0; bj < 2; ++bj) { const f32x4 v0 = acc[ai][bj][m][0] * gq[bj][0] * r, v1 = acc[ai][bj][m][1] * gq[bj][1] * r;
                        u32x4 w; w.x = cvtpk(v0[0], v0[1]); w.y = cvtpk(v0[2], v0[3]); w.z = cvtpk(v1[0], v1[1]); w.w = cvtpk(v1[2], v1[3]);
                        *(u32x4*)(q + row * 1536 + head * QKD + 32 * bj + 8 * fq) = w; }
                    EPI_FENCE(); }
        } else {
            const f32x4 g1 = *(const f32x4*)(g_qr + 4 * fq), g2 = *(const f32x4*)(g_qr + 16 + 4 * fq);
#pragma unroll
            for (int ai = 0; ai < 2; ++ai) {
                f32x4 t01[4], t23[4];
#pragma unroll
                for (int m = 0; m < 4; ++m) { const f32x2* tp = tab + (size_t)row_pos(row0 + ai * 128 + m * 16) * 16 + 4 * fq; t01[m] = *(const f32x4*)tp; t23[m] = *(const f32x4*)(tp + 2); }
#pragma unroll
                for (int m = 0; m < 4; ++m) { const int rowi = row0 + ai * 128 + m * 16; const size_t row = (size_t)rowi;
                    const f32x4 cs01 = t01[m], cs23 = t23[m];
                    const float cc[4] = {cs01[0], cs01[2], cs23[0], cs23[2]}, sn[4] = {cs01[1], cs01[3], cs23[1], cs23[3]};
#pragma unroll
                    for (int bj = 0; bj < 2; ++bj) { const int head = 8 * (pn - 4) + 4 * bj + wc;
                        const f32x4 a = acc[ai][bj][m][0], b = acc[ai][bj][m][1];
                        float ss = (a[0] * a[0] + a[1] * a[1]) + (a[2] * a[2] + a[3] * a[3]) + (b[0] * b[0] + b[1] * b[1]) + (b[2] * b[2] + b[3] * b[3]);
                        ss = rowsum4(ss);
                        const float rq = rqv[ai][m], r = rsqrtf(rq * rq * ss * (1.0f / 32.0f) + EPS) * rq * QSCALE;
                        float o1[4], o2[4];
#pragma unroll
                        for (int i = 0; i < 4; ++i) { const float x1 = a[i] * g1[i] * r, x2 = b[i] * g2[i] * r; o1[i] = x1 * cc[i] - x2 * sn[i]; o2[i] = x1 * sn[i] + x2 * cc[i]; }
                        u32x2 w; w.x = cvtpk(o1[0], o1[1]); w.y = cvtpk(o1[2], o1[3]); *(u32x2*)(q + row * 1536 + head * QKD + 64 + 4 * fq) = w;
                        w.x = cvtpk(o2[0], o2[1]); w.y = cvtpk(o2[2], o2[3]); *(u32x2*)(q + row * 1536 + head * QKD + 80 + 4 * fq) = w; }
                    EPI_FENCE(); }
            }
        }
    }
};

struct EpiKV {
    bf16_t* kn; bf16_t* v; const float* g_kn;
    static DI int rowtile(int pm) { return pm; }
    DI void prefetch(LAS unsigned char*, int, int, int, int) const {}
    DI void operator()(const AccT& acc, int pm, int pn, int wr, int wc, int fr, int fq, LAS unsigned char* lds, int slot) const {
        { const int l_ = fresh_lane(); fr = l_ & 15; fq = l_ >> 4; }
        const int row0 = pm * 256 + wr * 64 + fr;
        const int head = 4 * (pn & 3) + wc;
        f32x4 gk[2][2];
#pragma unroll
        for (int bj = 0; bj < 2; ++bj)
#pragma unroll
            for (int n = 0; n < 2; ++n) gk[bj][n] = *(const f32x4*)(g_kn + 32 * bj + 8 * fq + 4 * n);
#pragma unroll
        for (int ai = 0; ai < 2; ++ai)
#pragma unroll
            for (int m = 0; m < 4; ++m) { const size_t row = (size_t)(row0 + ai * 128 + m * 16);
                if (pn < 4) {
                    float ss = 0.f;
#pragma unroll
                    for (int bj = 0; bj < 2; ++bj)
#pragma unroll
                        for (int n = 0; n < 2; ++n) { const f32x4 x = acc[ai][bj][m][n]; ss += (x[0] * x[0] + x[1] * x[1]) + (x[2] * x[2] + x[3] * x[3]); }
                    ss = rowsum4(ss);
                    const float r = rsqrtf(ss * (1.0f / 64.0f) + EPS);
#pragma unroll
                    for (int bj = 0; bj < 2; ++bj) { const f32x4 v0 = acc[ai][bj][m][0] * gk[bj][0] * r, v1 = acc[ai][bj][m][1] * gk[bj][1] * r;
                        u32x4 w; w.x = cvtpk(v0[0], v0[1]); w.y = cvtpk(v0[2], v0[3]); w.z = cvtpk(v1[0], v1[1]); w.w = cvtpk(v1[2], v1[3]);
                        *(u32x4*)(kn + row * 1024 + head * 64 + 32 * bj + 8 * fq) = w; }
                } else {
#pragma unroll
                    for (int bj = 0; bj < 2; ++bj) { const f32x4 v0 = acc[ai][bj][m][0], v1 = acc[ai][bj][m][1];
                        u32x4 w; w.x = cvtpk(v0[0], v0[1]); w.y = cvtpk(v0[2], v0[3]); w.z = cvtpk(v1[0], v1[1]); w.w = cvtpk(v1[2], v1[3]);
                        *(u32x4*)(v + row * 1024 + head * 64 + 32 * bj + 8 * fq) = w; }
                }
                EPI_FENCE(); }
    }
};

struct EpiOut {
    const float* xp; bf16_t* xmb; float* ssrow;
    static DI int rowtile(int pm) { return pm; }
    DI void prefetch(LAS unsigned char*, int, int, int, int) const {}
    DI void operator()(const AccT& acc, int pm, int pn, int wr, int wc, int fr, int fq, LAS unsigned char* lds, int slot) const {
        { const int l_ = fresh_lane(); fr = l_ & 15; fq = l_ >> 4; }
        const int row0 = pm * 256 + wr * 64 + fr, cl = pn * 256 + wc * 32 + 8 * fq;
#pragma unroll
        for (int ai = 0; ai < 2; ++ai)
#pragma unroll
            for (int m = 0; m < 4; ++m) { const size_t row = (size_t)(row0 + ai * 128 + m * 16);
                const float* xr = xp + row * DM;
                float ss = 0.f;
#pragma unroll
                for (int bj = 0; bj < 2; ++bj) { const int c = cl + 128 * bj; const f32x4 v = *(const f32x4*)(xr + c) + acc[ai][bj][m][0], v2 = *(const f32x4*)(xr + c + 4) + acc[ai][bj][m][1];
                        u32x4 w; w.x = cvtpk(v[0], v[1]); w.y = cvtpk(v[2], v[3]); w.z = cvtpk(v2[0], v2[1]); w.w = cvtpk(v2[2], v2[3]); *(u32x4*)(xmb + (row + 2) * DM + c) = w;
                        ss += ((v[0] * v[0] + v[1] * v[1]) + (v[2] * v[2] + v[3] * v[3])) + ((v2[0] * v2[0] + v2[1] * v2[1]) + (v2[2] * v2[2] + v2[3] * v2[3])); }
                ss = rowsum4(ss);
                if (fq == 0) (void)__hip_atomic_fetch_add(ssrow + row + 2, ss, __ATOMIC_RELAXED, __HIP_MEMORY_SCOPE_AGENT); }
    }
};

constexpr int UP_SLOT0 = 131072 + 1024, UP_SLOT_BYTES = 5120;
template <bool FAST>
struct EpiUp {
    const float* ssrow; const float* cws; const float* st; bf16_t* hff; float* o_pffn; float* o_sffn;
    static constexpr int N_FAST = 62, N_SLOW = 7;
    static DI int rowtile(int pm) {
        if (FAST) { int r = pm + 1; if (r >= 16) ++r; if (r >= 33) ++r; if (r >= 49) ++r; return r; }
        return pm == 0 ? 0 : pm == 1 ? 16 : pm == 2 ? 33 : pm == 3 ? 49 : 62 + pm;
    }
    DI void prefetch(LAS unsigned char* lds, int wid, int pm, int pn, int slot) const {
        const int lane = fresh_lane();
        LAS unsigned char* sb = lds + UP_SLOT0 + slot * UP_SLOT_BYTES;
        const float* src = cws + (wid & 3) * NUP + (wid >> 2) * DFF + pn * 128 + lane;
        __builtin_amdgcn_global_load_lds((const unsigned*)src, (LAS unsigned*)(sb + wid * 512), 4, 0, 0);
        __builtin_amdgcn_global_load_lds((const unsigned*)(src + 64), (LAS unsigned*)(sb + wid * 512 + 256), 4, 0, 0);
        if (wid < 4) __builtin_amdgcn_global_load_lds((const unsigned*)(ssrow + (pm * 248 + 62 * wid + lane)), (LAS unsigned*)(sb + 4096 + wid * 256), 4, 0, 0);
    }
    DI void operator()(const AccT& acc, int pm, int pn, int wr, int wc, int fr, int fq, LAS unsigned char* lds, int slot) const {
        const LAS float* P = (const LAS float*)(lds + UP_SLOT0 + slot * UP_SLOT_BYTES);
        if constexpr (FAST) {
#pragma unroll
            for (int ai = 0; ai < 2; ++ai) {
                { const int l_ = fresh_lane(); fr = l_ & 15; fq = l_ >> 4; }
                const int seg = 2 * ai + wr, e0 = pm * 248 + 62 * seg - 2 + 4 * fr;
                const f32x4 ss4 = *(const LAS f32x4*)(P + 1024 + seg * 64 + 4 * fr);
                float r2[4];
#pragma unroll
                for (int m = 0; m < 4; ++m) r2[m] = rsqrtf(ss4[m] * (1.0f / DM) + EPS);
                u32x2 hpa[4];
#pragma unroll
                for (int n = 0; n < 2; ++n) { const int cc = wc * 32 + 8 * fq + 4 * n, ch = pn * 128 + cc;
                    f32x4 prm[8];
#pragma unroll
                    for (int k = 0; k < 8; ++k) prm[k] = *(const LAS f32x4*)(P + k * 128 + cc);
                    unsigned hp0[4];
#pragma unroll
                    for (int ip = 0; ip < 2; ++ip) {
                        float hres[4][2];
#pragma unroll
                        for (int ii = 0; ii < 2; ++ii) { const int i = 2 * ip + ii;
                            const float wg0 = prm[0][i], wg1 = prm[1][i], wg2 = prm[2][i], bg = prm[3][i], wv0 = prm[4][i], wv1 = prm[5][i], wv2 = prm[6][i], bv = prm[7][i];
                            float xg[4], xv[4];
#pragma unroll
                            for (int m = 0; m < 4; ++m) { xg[m] = acc[ai][0][m][n][i] * r2[m]; xv[m] = acc[ai][1][m][n][i] * r2[m]; }
                            float cg[4], cv[4];
                            cg[0] = wg2 * xg[0] + bg;                               cv[0] = wv2 * xv[0] + bv;
                            cg[1] = wg2 * xg[1] + (wg1 * xg[0] + bg);               cv[1] = wv2 * xv[1] + (wv1 * xv[0] + bv);
                            cg[2] = wg2 * xg[2] + (wg1 * xg[1] + (wg0 * xg[0] + bg)); cv[2] = wv2 * xv[2] + (wv1 * xv[1] + (wv0 * xv[0] + bv));
                            cg[3] = wg2 * xg[3] + (wg1 * xg[2] + (wg0 * xg[1] + bg)); cv[3] = wv2 * xv[3] + (wv1 * xv[2] + (wv0 * xv[1] + bv));
                            asm("s_nop 1\n\t"
                                "v_fmac_f32_dpp %0, %4, %6 row_ror:1 row_mask:0xf bank_mask:0xf\n\tv_fmac_f32_dpp %0, %5, %7 row_ror:1 row_mask:0xf bank_mask:0xf\n\tv_fmac_f32_dpp %1, %4, %7 row_ror:1 row_mask:0xf bank_mask:0xf\n\t"
                                "v_fmac_f32_dpp %2, %8, %10 row_ror:1 row_mask:0xf bank_mask:0xf\n\tv_fmac_f32_dpp %2, %9, %11 row_ror:1 row_mask:0xf bank_mask:0xf\n\tv_fmac_f32_dpp %3, %8, %11 row_ror:1 row_mask:0xf bank_mask:0xf"
                                : "+v"(cg[0]), "+v"(cg[1]), "+v"(cv[0]), "+v"(cv[1])
                                : "v"(xg[3]), "v"(xg[2]), "v"(wg1), "v"(wg0), "v"(xv[3]), "v"(xv[2]), "v"(wv1), "v"(wv0));
#pragma unroll
                            for (int m = 0; m < 4; ++m) hres[m][ii] = cg[m] * cv[m] * __builtin_amdgcn_rcpf(1.0f + __builtin_amdgcn_exp2f(cg[m]));
                        }
#pragma unroll
                        for (int m = 0; m < 4; ++m) { const unsigned pk = cvtpk(hres[m][0], hres[m][1]);
                            if (ip == 0) hp0[m] = pk;
                            else if (n == 0) { hpa[m].x = hp0[m]; hpa[m].y = pk; }
                            else if (m >= 2 || fr > 0) { u32x4 w; w.x = hpa[m].x; w.y = hpa[m].y; w.z = hp0[m]; w.w = pk; *(u32x4*)(hff + (size_t)(e0 + m) * DFF + ch - 4) = w; } }
                    }
                    EPI_FENCE();
                }
            }
            return;
        }
#pragma unroll
        for (int ai = 0; ai < 2; ++ai) {
            { const int l_ = fresh_lane(); fr = l_ & 15; fq = l_ >> 4; }
            const int e0 = pm * 248 + 62 * (2 * ai + wr) - 2 + fr;
            float r2[4];
#pragma unroll
            for (int m = 0; m < 4; ++m) r2[m] = rsqrtf(P[1024 + (2 * ai + wr) * 64 + 16 * m + fr] * (1.0f / DM) + EPS);
            unsigned long long bnd[4];
#pragma unroll
            for (int m = 0; m < 4; ++m) { const int j = 16 * m + fr, e = e0 + 16 * m; bool nd = false;
                if (j >= 2 && e < MT) { const int t = e < MP ? (e & (PT - 1)) : ((e - MP) & (ST - 1)); const int T = e < MP ? PT : ST; nd = (t < 2) || (t >= T - 2); }
                bnd[m] = __builtin_amdgcn_ballot_w64(nd); }
#pragma unroll
            for (int n = 0; n < 2; ++n) { const int cc = wc * 32 + 8 * fq + 4 * n, ch = pn * 128 + cc;
                f32x4 prm[8];
#pragma unroll
                for (int k = 0; k < 8; ++k) prm[k] = *(const LAS f32x4*)(P + k * 128 + cc);
                unsigned hp0[4];
#pragma unroll
                for (int ip = 0; ip < 2; ++ip) {
                    float hres[4][2];
#pragma unroll
                    for (int ii = 0; ii < 2; ++ii) { const int i = 2 * ip + ii;
                        const float wg0 = prm[0][i], wg1 = prm[1][i], wg2 = prm[2][i], bg = prm[3][i], wv0 = prm[4][i], wv1 = prm[5][i], wv2 = prm[6][i], bv = prm[7][i];
                        float pg = 0.f, pv = 0.f;
#pragma unroll
                        for (int m = 0; m < 4; ++m) {
                            const float xg = acc[ai][0][m][n][i] * r2[m], xv = acc[ai][1][m][n][i] * r2[m];
                            if (FAST) {
                                const float sg1 = fr == 15 ? pg : xg, sg2 = fr >= 14 ? pg : xg, sv1 = fr == 15 ? pv : xv, sv2 = fr >= 14 ? pv : xv;
                                float cg = wg2 * xg + bg, cv = wv2 * xv + bv;
                                asm("s_nop 1\n\tv_fmac_f32_dpp %0, %2, %4 row_ror:1 row_mask:0xf bank_mask:0xf\n\tv_fmac_f32_dpp %0, %3, %5 row_ror:2 row_mask:0xf bank_mask:0xf\n\t"
                                    "v_fmac_f32_dpp %1, %6, %8 row_ror:1 row_mask:0xf bank_mask:0xf\n\tv_fmac_f32_dpp %1, %7, %9 row_ror:2 row_mask:0xf bank_mask:0xf"
                                    : "+v"(cg), "+v"(cv) : "v"(sg1), "v"(sg2), "v"(wg1), "v"(wg0), "v"(sv1), "v"(sv2), "v"(wv1), "v"(wv0));
                                pg = xg; pv = xv;
                                hres[m][ii] = cg * cv * __builtin_amdgcn_rcpf(1.0f + __builtin_amdgcn_exp2f(cg));
                                continue;
                            }
                            float g1 = dpp_mov<0x121>(fr == 15 ? pg : xg), g2 = dpp_mov<0x122>(fr >= 14 ? pg : xg);
                            float v1 = dpp_mov<0x121>(fr == 15 ? pv : xv), v2 = dpp_mov<0x122>(fr >= 14 ? pv : xv);
                            pg = xg; pv = xv;
                            if (!FAST && bnd[m] != 0ull) {
                                const int j = 16 * m + fr, e = e0 + 16 * m;
                                if (j >= 2 && e < MT) {
                                    const int t = e < MP ? (e & (PT - 1)) : ((e - MP) & (ST - 1));
                                    const int T = e < MP ? PT : ST;
                                    if (t < 2) {
                                        float s0g = 0.f, s1g = 0.f, s0v = 0.f, s1v = 0.f;
                                        if (e >= MP) { const float* sb = st + (size_t)((e - MP) >> 5) * 2 * NUP + ch + i; s0g = sb[0]; s1g = sb[NUP]; s0v = sb[DFF]; s1v = sb[NUP + DFF]; }
                                        if (t == 0) { g1 = s1g; g2 = s0g; v1 = s1v; v2 = s0v; } else { g2 = s1g; v2 = s1v; }
                                    }
                                    if (t >= T - 2) {
                                        float* ob = (e < MP ? o_pffn + ((size_t)(e >> 12) * 2 + (t - (T - 2))) * NUP : o_sffn + ((size_t)((e - MP) >> 5) * 2 + (t - (T - 2))) * NUP) + ch + i;
                                        ob[0] = xg; ob[DFF] = xv; }
                                }
                            }
                            const float cg = wg0 * g2 + wg1 * g1 + wg2 * xg + bg, cv = wv0 * v2 + wv1 * v1 + wv2 * xv + bv;
                            hres[m][ii] = cg * cv * __builtin_amdgcn_rcpf(1.0f + __builtin_amdgcn_exp2f(cg));
                        }
                    }
#pragma unroll
                    for (int m = 0; m < 4; ++m) { const int j = 16 * m + fr, e = e0 + 16 * m; const unsigned pk = cvtpk(hres[m][0], hres[m][1]);
                        if (ip == 0) hp0[m] = pk; else if (j >= 2 && (FAST || e < MT)) { u32x2 w; w.x = hp0[m]; w.y = pk; *(u32x2*)(hff + (size_t)e * DFF + ch) = w; } }
                    if (!FAST) EPI_FENCE();
                }
                EPI_FENCE();
            }
        }
    }
};
namespace pg8 { template <> struct RowPerm<EpiUp<true>> { static constexpr bool v = true; }; }

struct EpiDown {
    const bf16_t* xmb; float* y;
    static DI int rowtile(int pm) { return pm; }
    DI void prefetch(LAS unsigned char*, int, int, int, int) const {}
    DI void operator()(const AccT& acc, int pm, int pn, int wr, int wc, int fr, int fq, LAS unsigned char* lds, int slot) const {
        { const int l_ = fresh_lane(); fr = l_ & 15; fq = l_ >> 4; }
        const int row0 = pm * 256 + wr * 64 + fr, cl = pn * 256 + wc * 32 + 4 * fq;
#pragma unroll
        for (int ai = 0; ai < 2; ++ai)
#pragma unroll
            for (int m = 0; m < 4; ++m) { const size_t row = (size_t)(row0 + ai * 128 + m * 16); float* yr = y + row * DM; const bf16_t* xr = xmb + (row + 2) * DM;
#pragma unroll
                for (int bj = 0; bj < 2; ++bj)
#pragma unroll
                    for (int n = 0; n < 2; ++n) { const int c = cl + 128 * bj + 16 * n; const u32x2 w = *(const u32x2*)(xr + c);
                        *(f32x4*)(yr + c) = (f32x4){bflo(w.x), bfhi(w.x), bflo(w.y), bfhi(w.y)} + acc[ai][bj][m][n]; } }
    }
};

constexpr int NWAVES = 8, NTHREADS = 512;
constexpr int RING_BYTES = 131072, LDS_BYTES = 147456;
constexpr int N_PHASES = 8;

struct Args { const float* in[30]; float* out; unsigned char* ws; int ph_lo, ph_hi; };

struct Frame {
    LAS unsigned char* lds; int wave, G, bid; unsigned char* ws; float* out;
    DI const float* in(int i) const { const LAS unsigned* p = (const LAS unsigned*)(lds + RING_BYTES) + 2 * i; const unsigned lo_ = __builtin_amdgcn_readfirstlane(p[0]), hi_ = __builtin_amdgcn_readfirstlane(p[1]);
        return (const float*)(((unsigned long long)hi_ << 32) | lo_); }
};

DI void tr_item(const float* W, int ldw, const float* fold, bf16_t* WT, int K, int k0, int nrow0, int sc, LAS float* scr, int lane, float cs = 1.0f) {
    f32x4 v[8];
#pragma unroll
    for (int i = 0; i < 8; ++i) { const int kk = (lane >> 3) + 8 * i; v[i] = (f32x4){0.f, 0.f, 0.f, 0.f};
        if (sc >= 0) { v[i] = *(const f32x4*)(W + (size_t)(k0 + kk) * ldw + sc) * cs; if (fold) v[i] = v[i] * fold[k0 + kk]; } }
#pragma unroll
    for (int i = 0; i < 8; ++i) { const int kk = (lane >> 3) + 8 * i; LAS float* d = scr + kk * 33 + 4 * (lane & 7); d[0] = v[i][0]; d[1] = v[i][1]; d[2] = v[i][2]; d[3] = v[i][3]; }
    LDS_WAIT();
    const int c = lane & 7;
#pragma unroll
    for (int j = 0; j < 4; ++j) { const int n = (lane >> 3) + 8 * j; const LAS float* s = scr + (8 * c) * 33 + n;
        u32x4 o; o.x = cvtpk(s[0 * 33], s[1 * 33]); o.y = cvtpk(s[2 * 33], s[3 * 33]); o.z = cvtpk(s[4 * 33], s[5 * 33]); o.w = cvtpk(s[6 * 33], s[7 * 33]);
        *(u32x4*)(WT + (size_t)(nrow0 + n) * K + k0 + 8 * c) = o; }
    LDS_WAIT();
}
DI int dperm(int cc, int bj) { return 32 * bj + 8 * ((cc >> 2) & 3) + 4 * ((cc >> 4) & 1) + (cc & 3); }
DI int src_win(int n) { if (n < 416) return n; if (n < 512) return -1; const int s_ = n - 512; return 416 + (s_ & ~31) + dperm(s_ & 31, 0); }
DI int src_wqb(int n) { const int pn = n >> 8, c = n & 255, bj = c >> 7, wc = (c >> 5) & 3, cc = c & 31;
    if (pn < 4) return (4 * pn + wc) * QKD + dperm(cc, bj);
    return (8 * (pn - 4) + 4 * bj + wc) * QKD + 64 + cc; }
DI int src_wkvb(int n) { const int pn = n >> 8, c = n & 255, bj = c >> 7, wc = (c >> 5) & 3, cc = c & 31;
    if (pn < 4) return (4 * pn + wc) * 128 + dperm(cc, bj);
    return (4 * (pn - 4) + wc) * 128 + 64 + dperm(cc, bj); }
DI int src_wup(int n) { const int pn = n >> 8, c = n & 255; return (c >> 7) * DFF + 128 * pn + (c & 96) + dperm(c & 31, 0); }

struct TrDesc { const float* W; const float* fold; bf16_t* WT; int ldw, K, k0, nrow0, sc; };
DI TrDesc late_desc(Frame& F, int r, int lane) {
    constexpr int I_OUT = 16 * 32, I_UP = 16 * 176;
    unsigned char* ws = F.ws;
    if (r < I_OUT) { const int kb = r / 32, nb = r % 32; return TrDesc{F.in(24), nullptr, (bf16_t*)(ws + WS_WOUT), 1024, 1024, 64 * kb, 32 * nb, 32 * nb + dperm(4 * (lane & 7), 0)}; }
    r -= I_OUT;
    if (r < I_UP) { const int kb = r / 176, nb = r % 176; return TrDesc{F.in(26), F.in(25), (bf16_t*)(ws + WS_WUP), NUP, 1024, 64 * kb, 32 * nb, src_wup(32 * nb + 4 * (lane & 7))}; }
    r -= I_UP;
    { const int kb = r / 32, nb = r % 32; return TrDesc{F.in(29), nullptr, (bf16_t*)(ws + WS_WDOWN), 1024, DFF, 64 * kb, 32 * nb, 32 * nb + 4 * (lane & 7)}; }
}
DI void tr_issue(const TrDesc& d, f32x4 (&v)[8], float (&fv)[8], int lane) {
#pragma unroll
    for (int i = 0; i < 8; ++i) { const int kk = (lane >> 3) + 8 * i; v[i] = *(const f32x4*)(d.W + (size_t)(d.k0 + kk) * d.ldw + d.sc); fv[i] = d.fold ? d.fold[d.k0 + kk] : 1.0f; }
}
DI void tr_finish(const TrDesc& d, const f32x4 (&v)[8], const float (&fv)[8], LAS float* scr, int lane) {
#pragma unroll
    for (int i = 0; i < 8; ++i) { const int kk = (lane >> 3) + 8 * i; LAS float* dd = scr + kk * 33 + 4 * (lane & 7); const f32x4 x = v[i] * fv[i]; dd[0] = x[0]; dd[1] = x[1]; dd[2] = x[2]; dd[3] = x[3]; }
    LDS_WAIT();
    const int c = lane & 7;
#pragma unroll
    for (int j = 0; j < 4; ++j) { const int n = (lane >> 3) + 8 * j; const LAS float* sp = scr + (8 * c) * 33 + n;
        u32x4 o; o.x = cvtpk(sp[0 * 33], sp[1 * 33]); o.y = cvtpk(sp[2 * 33], sp[3 * 33]); o.z = cvtpk(sp[4 * 33], sp[5 * 33]); o.w = cvtpk(sp[6 * 33], sp[7 * 33]);
        *(u32x4*)(d.WT + (size_t)(d.nrow0 + n) * d.K + d.k0 + 8 * c) = o; }
    LDS_WAIT();
}
constexpr int LATE_ITEMS = 16 * 32 + 16 * 176 + 44 * 32, LATE_DOWN0 = 16 * 32 + 16 * 176;
DI void late_weights(Frame& F, int worker, int nworkers, int it_lo, int NIT) {
    LAS float* scr = (LAS float*)(F.lds + F.wave * 16384);
    const int lane = fresh_lane();
    int r0 = it_lo + worker; if (r0 >= NIT) return;
    TrDesc dc = late_desc(F, r0, lane); f32x4 vc[8]; float fc[8];
    tr_issue(dc, vc, fc, lane);
    for (;;) {
        const int rn = r0 + nworkers; const bool more = rn < NIT;
        TrDesc dn = dc; f32x4 vn[8]; float fn[8];
        if (more) { dn = late_desc(F, rn, lane); tr_issue(dn, vn, fn, lane); }
        tr_finish(dc, vc, fc, scr, lane);
        if (!more) break;
        dc = dn; r0 = rn;
#pragma unroll
        for (int i = 0; i < 8; ++i) { vc[i] = vn[i]; fc[i] = fn[i]; }
    }
}

constexpr int CACHE_P0 = 2;
constexpr int CACHE_LATE = 8;
DI void cache_convert(Frame& F, int gt, int NGT, int s_lo, int s_hi) {
    unsigned char* ws = F.ws;
    { const float* cl = F.in(2); const float* ck = F.in(3);
      const int l_lo = s_lo * PAST * (KVL / 8), l_hi = s_hi * PAST * (KVL / 8);
      for (int i0 = l_lo + gt; i0 < l_hi; i0 += 4 * NGT) {
        f32x4 a[4], bq[4];
#pragma unroll
        for (int q = 0; q < 4; ++q) { int i = i0 + q * NGT; i = i < l_hi ? i : l_hi - 1; const float* sp = cl + (size_t)(i >> 4) * KVL + (i & 15) * 8; a[q] = *(const f32x4*)sp; bq[q] = *(const f32x4*)(sp + 4); }
#pragma unroll
        for (int q = 0; q < 4; ++q) { const int i = i0 + q * NGT; if (i >= l_hi) break; const int row = i >> 4, c8 = (i & 15) * 8, b = row >> 12, j = row & 4095;
            u32x4 w; w.x = cvtpk(a[q][0], a[q][1]); w.y = cvtpk(a[q][2], a[q][3]); w.z = cvtpk(bq[q][0], bq[q][1]); w.w = cvtpk(bq[q][2], bq[q][3]);
            *(u32x4*)((bf16_t*)(ws + WS_LAT) + (size_t)(MP + b * SKEYS + j) * KVL + c8) = w; } }
      const int r_lo = s_lo * PAST * (ROPE / 8), r_hi = s_hi * PAST * (ROPE / 8);
      for (int i = r_lo + gt; i < r_hi; i += NGT) { const int row = i >> 2, c8 = (i & 3) * 8, b = row >> 12, j = row & 4095;
        const float* sp = ck + (size_t)row * ROPE + c8; const f32x4 a = *(const f32x4*)sp, bq = *(const f32x4*)(sp + 4);
        u32x4 w; w.x = cvtpk(a[0], a[1]); w.y = cvtpk(a[2], a[3]); w.z = cvtpk(bq[0], bq[1]); w.w = cvtpk(bq[2], bq[3]);
        *(u32x4*)((bf16_t*)(ws + WS_KR) + (size_t)(MP + b * SKEYS + j) * ROPE + c8) = w; } }
}

DI void p0_prologue(Frame& F) {
    LAS float* scr = (LAS float*)(F.lds + F.wave * 16384);
    const int lane = fresh_lane(), tid = F.wave * 64 + lane;
    const int gw = F.bid * NWAVES + F.wave, NGW = F.G * NWAVES;
    unsigned char* ws = F.ws;
    constexpr int I_IN = 16 * 112, I_QB = 4 * 48, I_KVB = 2 * 64, I_KVN = 2 * 64, I_LRU = 16 * 8;
    constexpr int NITEMS = I_IN + I_QB + I_KVB + I_KVN + I_LRU;
    for (int it = gw; it < NITEMS; it += NGW) {
        int r = it;
        if (r < I_IN) { const int kb = r / 112, nb = r % 112; tr_item(F.in(8), 3488, nullptr, (bf16_t*)(ws + WS_WIN), 1024, 64 * kb, 32 * nb, src_win(32 * nb + 4 * (lane & 7)), scr, lane, nb >= 48 ? -LOG2E : 1.0f); continue; } r -= I_IN;
        if (r < I_QB) { const int kb = r / 48, nb = r % 48; tr_item(F.in(10), 1536, F.in(9), (bf16_t*)(ws + WS_WQB), 256, 64 * kb, 32 * nb, src_wqb(32 * nb + 4 * (lane & 7)), scr, lane); continue; } r -= I_QB;
        if (r < I_KVB) { const int kb = r / 64, nb = r % 64; tr_item(F.in(12), 2048, nullptr, (bf16_t*)(ws + WS_WKVB), 128, 64 * kb, 32 * nb, src_wkvb(32 * nb + 4 * (lane & 7)), scr, lane); continue; } r -= I_KVB;
        if (r < I_KVN) { const int kb = r / 64, nb = r % 64; tr_item(F.in(12), 2048, nullptr, (bf16_t*)(ws + WS_WKVN), 128, 64 * kb, 32 * nb, 32 * nb + 4 * (lane & 7), scr, lane); continue; } r -= I_KVN;
        { const int mat = r >> 3, sub = r & 7, blk = mat >> 1, bj = mat & 1, kb = sub >> 2, nb = sub & 3;
            tr_item((bj ? F.in(21) : F.in(19)) + (size_t)blk * 16384, 128, nullptr, (bf16_t*)(ws + WS_WLRU), 128, 64 * kb, blk * 256 + bj * 128 + 32 * nb, 32 * nb + dperm(4 * (lane & 7), 0), scr, lane); }
    }
    const float* gm = F.in(7);
    { const float* x0 = F.in(0); const float* x1 = F.in(1);
      for (int m0 = 2 * gw; m0 < MT; m0 += 2 * NGW) {
        f32x4 v[2][4]; float s[2];
#pragma unroll
        for (int q = 0; q < 2; ++q) { const int m = m0 + q; const float* xr = m < MP ? x0 + (size_t)m * DM : x1 + (size_t)(m - MP) * DM; s[q] = 0.f;
#pragma unroll
            for (int j = 0; j < 4; ++j) { v[q][j] = *(const f32x4*)(xr + 4 * lane + 256 * j); s[q] += (v[q][j][0] * v[q][j][0] + v[q][j][1] * v[q][j][1]) + (v[q][j][2] * v[q][j][2] + v[q][j][3] * v[q][j][3]); } }
#pragma unroll
        for (int q = 0; q < 2; ++q) { const float r = rsqrtf(wave_sum(s[q]) * (1.0f / DM) + EPS);
            bf16_t* o = (bf16_t*)(ws + WS_XN) + (size_t)(m0 + q) * DM;
#pragma unroll
            for (int j = 0; j < 4; ++j) { const f32x4 g = *(const f32x4*)(gm + 4 * lane + 256 * j); const f32x4 y = v[q][j] * g * r;
                u32x2 w; w.x = cvtpk(y[0], y[1]); w.y = cvtpk(y[2], y[3]); *(u32x2*)(o + 4 * lane + 256 * j) = w; } }
      } }
    const int gt = F.bid * NTHREADS + tid, NGT = F.G * NTHREADS;
    cache_convert(F, gt, NGT, 0, F.G == 256 ? CACHE_P0 : SB);
    for (int i = gt; i < MT; i += NGT) ((float*)(ws + WS_SSCQ))[i] = 0.f;
    for (int i = gt; i < XMB_ROWS + 2; i += NGT) ((float*)(ws + WS_SSROW))[i] = 0.f;
    for (int i = gt; i < 4 * NUP; i += NGT) { const int row = i / NUP, c = i - row * NUP;
        ((float*)(ws + WS_CWS))[i] = (row < 3 ? F.in(27)[i] : F.in(28)[c]) * (c < DFF ? -1.4426950408889634f : -0.6931471805599453f); }
    for (int i = gt; i < DM; i += NGT) { const float x = -F.in(23)[i]; ((float*)(ws + WS_SP8))[i] = -8.0f * (x > 15.f ? x : log1pf(__expf(x))); }
    for (int i = gt; i < SKEYS * 16; i += NGT) { const int pos = i >> 4, k = i & 15;
        const float inv = exp2f(-(float)k * (13.287712379549449f / 16.0f));
        const double rev = (double)((float)pos * inv) * 0.15915494309189535;
        const float fr_ = (float)(rev - floor(rev));
        ((f32x2*)(ws + WS_TAB))[i] = (f32x2){__builtin_amdgcn_cosf(fr_), __builtin_amdgcn_sinf(fr_)}; }
}

template <int GR>
DI void conv_rows(Frame& F, const int m0, const int c, const bf16_t* u, const float* cw, const float* cb, const float* cst) {
    const int t0 = m0 < MP ? (m0 & (PT - 1)) : ((m0 - MP) & (ST - 1)); const int T = m0 < MP ? PT : ST;
    u32x4 ux[GR + 3];
#pragma unroll
    for (int i = 0; i < GR + 3; ++i) { const int row = (t0 == 0 && i < 3) ? m0 : m0 - 3 + i;
        ux[i] = *(const u32x4*)(u + (size_t)row * DM + c); }
    float x[GR + 3][8];
#pragma unroll
    for (int i = 0; i < GR + 3; ++i) { const u32x4 w = ux[i];
        x[i][0] = bflo(w.x); x[i][1] = bfhi(w.x); x[i][2] = bflo(w.y); x[i][3] = bfhi(w.y); x[i][4] = bflo(w.z); x[i][5] = bfhi(w.z); x[i][6] = bflo(w.w); x[i][7] = bfhi(w.w); }
    if (t0 == 0) {
#pragma unroll
        for (int i = 0; i < 3; ++i) {
            if (m0 >= MP) { const float* sp = cst + ((size_t)((m0 - MP) >> 5) * 3 + i) * DM + c; const f32x4 a = *(const f32x4*)sp, b = *(const f32x4*)(sp + 4);
                x[i][0] = a[0]; x[i][1] = a[1]; x[i][2] = a[2]; x[i][3] = a[3]; x[i][4] = b[0]; x[i][5] = b[1]; x[i][6] = b[2]; x[i][7] = b[3]; }
            else {
#pragma unroll
                for (int e = 0; e < 8; ++e) x[i][e] = 0.f; } } }
    f32x4 w0[4], w1[4];
#pragma unroll
    for (int j = 0; j < 4; ++j) { w0[j] = *(const f32x4*)(cw + j * DM + c); w1[j] = *(const f32x4*)(cw + j * DM + c + 4); }
    const f32x4 b0 = *(const f32x4*)(cb + c), b1 = *(const f32x4*)(cb + c + 4);
    bf16_t* ucp = (bf16_t*)(F.ws + WS_UC);
#pragma unroll
    for (int r = 0; r < GR; ++r) { const int m = m0 + r, t = t0 + r;
        float y[8];
#pragma unroll
        for (int e = 0; e < 4; ++e) { y[e] = b0[e]; y[4 + e] = b1[e]; }
#pragma unroll
        for (int j = 0; j < 4; ++j)
#pragma unroll
            for (int e = 0; e < 4; ++e) { y[e] += w0[j][e] * x[r + j][e]; y[4 + e] += w1[j][e] * x[r + j][4 + e]; }
        u32x4 w; w.x = cvtpk(y[0], y[1]); w.y = cvtpk(y[2], y[3]); w.z = cvtpk(y[4], y[5]); w.w = cvtpk(y[6], y[7]);
        *(u32x4*)(ucp + (size_t)m * DM + c) = w;
        if (t >= T - 3) { float* oc = m < MP ? F.out + O_PCONV + ((size_t)(m >> 12) * 3 + (t - (T - 3))) * DM : F.out + O_SCONV + ((size_t)((m - MP) >> 5) * 3 + (t - (T - 3))) * DM;
            *(f32x4*)(oc + c) = (f32x4){x[r + 3][0], x[r + 3][1], x[r + 3][2], x[r + 3][3]}; *(f32x4*)(oc + c + 4) = (f32x4){x[r + 3][4], x[r + 3][5], x[r + 3][6], x[r + 3][7]}; } }
}
DI void conv_own_units(Frame& F, const pg8::StaticOrder& S) {
    const int tid = F.wave * 64 + fresh_lane();
    const bf16_t* u = (const bf16_t*)(F.out + O_Y); const float* cw = F.in(17); const float* cb = F.in(18); const float* cst = F.in(5);
    pg8::Unit un;
    for (int i = 0; S.next(i, un); ++i) conv_rows<8>(F, un.pm * 256 + (tid >> 4) * 8, un.pn * 128 + (tid & 15) * 8, u, cw, cb, cst);
    asm volatile("s_waitcnt vmcnt(0)" ::: "memory"); __syncthreads();
}

DI void lru_small(Frame& F) {
    const int lane = fresh_lane(), wid = F.wave, l15 = lane & 15, kq = lane >> 4;
    const bf16_t* uc = (const bf16_t*)(F.ws + WS_UC); const bf16_t* wl = (const bf16_t*)(F.ws + WS_WLRU);
    bf16_t* la = (bf16_t*)(F.ws + WS_LA); bf16_t* bt = (bf16_t*)(F.ws + WS_BT);
    const float* b_rg = F.in(20); const float* b_ig = F.in(22); const float* sp8 = (const float*)(F.ws + WS_SP8);
    for (int task = F.bid; task < (MS / 16) * 8; task += F.G) {
        const int rbk = task >> 3, blk = task & 7;
        if (wid == 0) conv_rows<4>(F, MP + rbk * 16 + (lane >> 4) * 4, blk * 128 + (lane & 15) * 8, (const bf16_t*)(F.out + O_Y), F.in(17), F.in(18), F.in(5));
        asm volatile("s_waitcnt vmcnt(0)" ::: "memory"); __syncthreads();
        const bf16_t* ap = uc + (size_t)(MP + rbk * 16 + l15) * DM + blk * 128 + 8 * kq;
        const bf16_t* bp = wl + (size_t)(blk * 256 + 16 * wid + l15) * 128 + 8 * kq;
        bf16x8 a[4], br[4], bi[4];
#pragma unroll
        for (int s = 0; s < 4; ++s) { a[s] = *(const bf16x8*)(ap + 32 * s); br[s] = *(const bf16x8*)(bp + 32 * s); bi[s] = *(const bf16x8*)(bp + (size_t)128 * 128 + 32 * s); }
        f32x4 cr = (f32x4){0.f, 0.f, 0.f, 0.f}, ci = cr;
#pragma unroll
        for (int s = 0; s < 4; ++s) { cr = __builtin_amdgcn_mfma_f32_16x16x32_bf16(a[s], br[s], cr, 0, 0, 0); ci = __builtin_amdgcn_mfma_f32_16x16x32_bf16(a[s], bi[s], ci, 0, 0, 0); }
        const int ch = blk * 128 + ((16 * wid + l15) & ~31) + dperm((16 * wid + l15) & 31, 0);
        const float brg = b_rg[ch], big = b_ig[ch], sp = sp8[ch];
#pragma unroll
        for (int r = 0; r < 4; ++r) { const size_t row = (size_t)MP + rbk * 16 + 4 * kq + r;
            const float uv = bf2f(uc[row * DM + ch]);
            const float rg = sigmoidf_(cr[r] + brg), ig = sigmoidf_(ci[r] + big);
            const float loga = rg * sp, m2 = 1.0f - __builtin_amdgcn_exp2f(2.0f * loga * LOG2E);
            la[row * DM + ch] = (bf16_t)(cvtpk(loga * LOG2E, 0.f) & 0xffffu);
            bt[row * DM + ch] = (bf16_t)(cvtpk(sqrtf(m2) * ig * uv, 0.f) & 0xffffu); }
    }
}

DI void scan_local_own(Frame& F, const pg8::StaticOrder& S) {
    const bf16_t* la = (const bf16_t*)(F.ws + WS_LA); const bf16_t* bt = (const bf16_t*)(F.ws + WS_BT);
    float* Ap = (float*)(F.ws + WS_AGG); float* Bp = Ap + PB * 64 * DM;
    const int tid = F.wave * 64 + fresh_lane();
    asm volatile("s_waitcnt vmcnt(0)" ::: "memory"); __syncthreads();
    pg8::Unit u;
    for (int i = 0; S.next(i, u); i += 2) {
        pg8::Unit v = u; const int which = tid >> 8; bool have = true;
        if (which == 1) have = S.next(i + 1, v);
        if (have) { const int seg4 = (tid >> 6) & 3, cp = v.pn * 64 + (tid & 63);
            const int row0 = v.pm * 256 + seg4 * 64, b = row0 >> 12, seg = (row0 & (PT - 1)) >> 6; const size_t base = (size_t)row0 * DM + 2 * cp;
            float A0 = 1.f, A1 = 1.f, H0 = 0.f, H1 = 0.f;
#pragma unroll 8
            for (int t = 0; t < 64; ++t) { const unsigned lw = *(const unsigned*)(la + base + (size_t)t * DM), bw = *(const unsigned*)(bt + base + (size_t)t * DM);
                const float a0 = __builtin_amdgcn_exp2f(bflo(lw)), a1 = __builtin_amdgcn_exp2f(bfhi(lw)); H0 = a0 * H0 + bflo(bw); H1 = a1 * H1 + bfhi(bw); A0 *= a0; A1 *= a1; }
            *(f32x2*)(Ap + ((size_t)b * 64 + seg) * DM + 2 * cp) = (f32x2){A0, A1}; *(f32x2*)(Bp + ((size_t)b * 64 + seg) * DM + 2 * cp) = (f32x2){H0, H1}; }
    }
}
constexpr int SCAN_EXTRA0 = (MT / 256) * 6 - 256;
DI void p5_scan_apply(Frame& F) {
    const bf16_t* la = (const bf16_t*)(F.ws + WS_LA); const bf16_t* bt = (const bf16_t*)(F.ws + WS_BT); bf16_t* gates = (bf16_t*)(F.ws + WS_GATES);
    const float* Ap = (const float*)(F.ws + WS_AGG); const float* Bp = Ap + PB * 64 * DM;
    const int NP = PB * 64 * 512, NS = SB * 512;
    const int tid = F.wave * 64 + fresh_lane();
    for (int it = 0;; ++it) {
        int idx;
        if (F.G == 256) { if (it == 0) idx = (F.bid >> 6) * 32768 + (((F.bid & 63) + 8 * F.wave) & 63) * 512 + tid;
            else if (it == 1 && F.bid >= SCAN_EXTRA0 && F.bid < SCAN_EXTRA0 + NS / NTHREADS) idx = NP + (F.bid - SCAN_EXTRA0) * NTHREADS + tid; else break; }
        else { idx = F.bid * NTHREADS + tid + it * F.G * NTHREADS; if (idx >= NP + NS) break; }
        float H0, H1; size_t row0; int nsteps; float* oh = nullptr; int cp;
        if (idx < NP) { cp = idx & 511; const int seg = (idx >> 9) & 63, b = idx >> 15; H0 = 0.f; H1 = 0.f;
            for (int s0 = 0; s0 < seg; s0 += 8) {
                f32x2 a[8], h[8];
#pragma unroll
                for (int q = 0; q < 8; ++q) { const int si = s0 + q < 63 ? s0 + q : 63; a[q] = *(const f32x2*)(Ap + ((size_t)b * 64 + si) * DM + 2 * cp); h[q] = *(const f32x2*)(Bp + ((size_t)b * 64 + si) * DM + 2 * cp); }
#pragma unroll
                for (int q = 0; q < 8; ++q) if (s0 + q < seg) { H0 = a[q][0] * H0 + h[q][0]; H1 = a[q][1] * H1 + h[q][1]; } }
            row0 = (size_t)b * PT + seg * 64; nsteps = 64; if (seg == 63) oh = F.out + O_PH + (size_t)b * DM + 2 * cp; }
        else { const int j = idx - NP; cp = j & 511; const int b = j >> 9; const f32x2 h = *(const f32x2*)(F.in(4) + (size_t)b * DM + 2 * cp); H0 = h[0]; H1 = h[1];
            row0 = (size_t)MP + b * ST; nsteps = ST; oh = F.out + O_SH + (size_t)b * DM + 2 * cp; }
        for (int t0 = 0; t0 < nsteps; t0 += 8) {
            unsigned lw[8], bw[8], gv[8];
#pragma unroll
            for (int t = 0; t < 8; ++t) { const size_t r = row0 + t0 + t; lw[t] = *(const unsigned*)(la + r * DM + 2 * cp); bw[t] = *(const unsigned*)(bt + r * DM + 2 * cp); gv[t] = *(const unsigned*)(gates + r * 2048 + 1024 + 2 * cp); }
#pragma unroll
            for (int t = 0; t < 8; ++t) { H0 = __builtin_amdgcn_exp2f(bflo(lw[t])) * H0 + bflo(bw[t]); H1 = __builtin_amdgcn_exp2f(bfhi(lw[t])) * H1 + bfhi(bw[t]); gv[t] = cvtpk(bflo(gv[t]) * H0, bfhi(gv[t]) * H1); }
#pragma unroll
            for (int t = 0; t < 8; ++t) *(unsigned*)(gates + (row0 + t0 + t) * 2048 + 1024 + 2 * cp) = gv[t];
        }
        if (oh) *(f32x2*)oh = (f32x2){H0, H1};
    }
}

struct FinOut {
    const float* xs; bf16_t* xmb; float* ssrow;
    DI void operator()(int row, int cb, int col, f32x4 sum, int lane) const {
        col = (col & ~31) + dperm(col & 31, 0);
        const size_t m = (size_t)MP + row; const f32x4 v = *(const f32x4*)(xs + (size_t)row * DM + col) + sum;
        u32x2 w; w.x = cvtpk(v[0], v[1]); w.y = cvtpk(v[2], v[3]); *(u32x2*)(xmb + (m + 2) * DM + col) = w;
        float ss = (v[0] * v[0] + v[1] * v[1]) + (v[2] * v[2] + v[3] * v[3]);
        ss += __shfl_xor(ss, 1); ss += __shfl_xor(ss, 2); ss += __shfl_xor(ss, 4); ss += __shfl_xor(ss, 8);
        if ((lane & 15) == 0) (void)__hip_atomic_fetch_add(ssrow + m + 2, ss, __ATOMIC_RELAXED, __HIP_MEMORY_SCOPE_AGENT); }
};
struct FinDown {
    const bf16_t* xmb; float* y;
    DI void operator()(int row, int cb, int col, f32x4 sum, int lane) const { const size_t m = (size_t)MP + row; const u32x2 w = *(const u32x2*)(xmb + (m + 2) * DM + col);
        *(f32x4*)(y + m * DM + col) = (f32x4){bflo(w.x), bfhi(w.x), bflo(w.y), bfhi(w.y)} + sum; }
};
template <int STEPS, class Fin>
DI void small_gemm(Frame& F, const bf16_t* A, int lda, const bf16_t* Bt, int ldb, const Fin& fin) {
    LAS char* lds = (LAS char*)F.lds;
    const int lane = fresh_lane(), wid = F.wave, tid = wid * 64 + lane, r32 = lane & 31, hi = lane >> 5;
    constexpr int BATCH = (STEPS % 11 == 0) ? 11 : 8;
    static_assert(STEPS % BATCH == 0, "small_gemm batch");
    for (int u = F.bid; u < (MS / 32) * 16; u += F.G) {
        const int rb = u >> 4, cb = u & 15;
        const bf16_t* ap = A + (size_t)(rb * 32 + r32) * lda + wid * STEPS * 16 + 8 * hi;
        const bf16_t* bp0 = Bt + (size_t)(cb * 64 + r32) * ldb + wid * STEPS * 16 + 8 * hi;
        const bf16_t* bp1 = bp0 + (size_t)32 * ldb;
        f32x16 acc0, acc1;
#pragma unroll
        for (int r = 0; r < 16; ++r) { acc0[r] = 0.f; acc1[r] = 0.f; }
        for (int s0 = 0; s0 < STEPS; s0 += BATCH) {
            bf16x8 a[BATCH], b0[BATCH], b1[BATCH];
#pragma unroll
            for (int s = 0; s < BATCH; ++s) { a[s] = *(const bf16x8*)(ap + (s0 + s) * 16); b0[s] = *(const bf16x8*)(bp0 + (s0 + s) * 16); b1[s] = *(const bf16x8*)(bp1 + (s0 + s) * 16); }
#pragma unroll
            for (int s = 0; s < BATCH; ++s) { acc0 = MFMA32(a[s], b0[s], acc0); acc1 = MFMA32(a[s], b1[s], acc1); }
        }
        LAS float* ob = (LAS float*)lds + wid * 2048;
#pragma unroll
        for (int r = 0; r < 16; ++r) { const int row = crow(r, hi); ob[row * 64 + r32] = acc0[r]; ob[row * 64 + 32 + r32] = acc1[r]; }
        __syncthreads();
        { const int row = tid >> 4, c4 = (tid & 15) * 4; f32x4 sum = (f32x4){0.f, 0.f, 0.f, 0.f};
#pragma unroll
          for (int w = 0; w < 8; ++w) sum += *(const LAS f32x4*)((const LAS float*)lds + w * 2048 + row * 64 + c4);
          fin(rb * 32 + row, cb, cb * 64 + c4, sum, lane); }
        __syncthreads();
    }
}

DI s16x4 vtr(const LAS char* p) { return __builtin_bit_cast(s16x4, __builtin_amdgcn_ds_read_tr16_b64_v4i16((LAS s16x4*)p)); }
constexpr int KCH = 1024;

DI float attn_negb(Frame& F) {
    float mqn = 0.f, mqr = 0.f, mkn = 0.f, mkr = 0.f;
    for (int i = 0; i < 64; ++i) { mqn = fmaxf(mqn, fabsf(F.in(13)[i])); mkn = fmaxf(mkn, fabsf(F.in(15)[i])); }
    for (int i = 0; i < 32; ++i) { mqr = fmaxf(mqr, fabsf(F.in(14)[i])); mkr = fmaxf(mkr, fabsf(F.in(16)[i])); }
    const float bq = sqrtf(64.f * mqn * mqn + 32.f * mqr * mqr), bk = sqrtf(64.f * mkn * mkn + 32.f * mkr * mkr);
    return -(bq * bk * QSCALE * 1.001f);
}

DI void merge_store8(const bf16_t* gates, bf16_t* mix, size_t m, int col, const float* o) {
    const u32x4 ga = *(const u32x4*)(gates + m * 2048 + col), rr = *(const u32x4*)(gates + m * 2048 + 1024 + col);
    u32x4 w;
    w.x = cvtpk(bflo(ga.x) * o[0] + bflo(rr.x), bfhi(ga.x) * o[1] + bfhi(rr.x)); w.y = cvtpk(bflo(ga.y) * o[2] + bflo(rr.y), bfhi(ga.y) * o[3] + bfhi(rr.y));
    w.z = cvtpk(bflo(ga.z) * o[4] + bflo(rr.z), bfhi(ga.z) * o[5] + bfhi(rr.z)); w.w = cvtpk(bflo(ga.w) * o[6] + bflo(rr.w), bfhi(ga.w) * o[7] + bfhi(rr.w));
    *(u32x4*)(mix + m * DM + col) = w;
}

constexpr int A_SLOT = 12288 + 8192, A_NS = 4;
constexpr int A_WSF = A_NS * A_SLOT, A_OST = A_WSF + 2048, A_END = A_OST + 8 * 4096;
static_assert(A_END <= 131072, "attention LDS");
#define VMWAIT(n) asm volatile("s_waitcnt vmcnt(" #n ")" ::: "memory")
DI void attn_prompt_unit(Frame& F, int b, int h, int qb, float negb) {
    LAS char* lds = (LAS char*)F.lds;
    const int lane = fresh_lane(), wid = F.wave, r32 = lane & 31, hi = lane >> 5;
    const bf16_t* KN = (const bf16_t*)(F.out + O_Y); const bf16_t* V = KN + (size_t)MP * DM;
    const bf16_t* KR = (const bf16_t*)(F.ws + WS_KR);
    const size_t rowbase = (size_t)b * PT; const int q0 = qb * 256;
    const bf16_t* Q = q_part(F.ws, rowbase + q0);
    const int NT = (q0 + 256) / 64, cw = (q0 + 32 * wid) / 64;
    const bf16_t* kng = KN + (rowbase + lane) * DM + h * 64 + wid * 8;
    const bf16_t* krg = KR + (rowbase + lane) * ROPE + (wid & 3) * 8;
    const bf16_t* vg = V + (rowbase + 16 * (wid & 3) + (lane >> 2)) * DM + h * 64 + (wid >> 2) * 32 + (lane & 3) * 8;
#define A_DMA(t) do { const int sl_ = ((t) & 3) * A_SLOT; const size_t adv_ = (size_t)(t) * 64; \
        __builtin_amdgcn_global_load_lds((const unsigned*)(kng + adv_ * DM), (LAS unsigned*)(lds + sl_ + wid * KCH), 16, 0, 0); \
        if (wid < 4) __builtin_amdgcn_global_load_lds((const unsigned*)(krg + adv_ * ROPE), (LAS unsigned*)(lds + sl_ + (8 + wid) * KCH), 16, 0, 0); \
        __builtin_amdgcn_global_load_lds((const unsigned*)(vg + adv_ * DM), (LAS unsigned*)(lds + sl_ + 12288 + wid * 1024), 16, 0, 0); } while (0)
    A_DMA(0); if (NT > 1) A_DMA(1); if (NT > 2) A_DMA(2);
    bf16x8 qf[6];
    { const bf16_t* qp = Q + (rowbase + q0 + wid * 32 + r32) * 1536 + h * QKD + 8 * hi;
#pragma unroll
      for (int s = 0; s < 6; ++s) qf[s] = *(const bf16x8*)(qp + 16 * s); }
    f32x16 o0, o1, negm;
#pragma unroll
    for (int r = 0; r < 16; ++r) { o0[r] = 0.f; o1[r] = 0.f; negm[r] = negb; }
    float lsum = 0.f;
    const int vrd = ((lane >> 4) & 1) * 32 + (lane & 3) * 8 + (4 * hi + ((lane & 15) >> 2)) * 64;
    for (int t = 0; t < NT; ++t) {
        { const int rem = NT - 1 - t;
          if (rem >= 2) { if (wid < 4) VMWAIT(6); else VMWAIT(4); }
          else if (rem == 1) { if (wid < 4) VMWAIT(3); else VMWAIT(2); }
          else VMWAIT(0); }
        __builtin_amdgcn_s_barrier(); asm volatile("" ::: "memory");
        if (t + 3 < NT) A_DMA(t + 3);
        if (t <= cw) {
            const LAS char* kb = lds + (t & 3) * A_SLOT + r32 * 16;
            f32x16 p0 = negm, p1 = negm;
#pragma unroll
            for (int s = 0; s < 6; ++s) { const bf16x8 a0 = *(const LAS bf16x8*)(kb + (2 * s + hi) * KCH), a1 = *(const LAS bf16x8*)(kb + (2 * s + hi) * KCH + 512);
                p0 = MFMA32(a0, qf[s], p0); p1 = MFMA32(a1, qf[s], p1); }
            float sacc = 0.f;
#pragma unroll
            for (int r = 0; r < 16; ++r) { p0[r] = __builtin_amdgcn_exp2f(p0[r]); p1[r] = __builtin_amdgcn_exp2f(p1[r]); sacc += p0[r] + p1[r]; }
            lsum += sacc;
            u32x4 pw[4];
#pragma unroll
            for (int e = 0; e < 4; ++e) { pw[0][e] = cvtpk(p0[2 * e], p0[2 * e + 1]); pw[1][e] = cvtpk(p0[8 + 2 * e], p0[8 + 2 * e + 1]); pw[2][e] = cvtpk(p1[2 * e], p1[2 * e + 1]); pw[3][e] = cvtpk(p1[8 + 2 * e], p1[8 + 2 * e + 1]); }
            const LAS char* vb = lds + (t & 3) * A_SLOT + 12288 + vrd;
#pragma unroll
            for (int s2 = 0; s2 < 4; ++s2) {
                const s16x4 l0 = vtr(vb + s2 * 1024), h0 = vtr(vb + s2 * 1024 + 512), l1 = vtr(vb + 4096 + s2 * 1024), h1 = vtr(vb + 4096 + s2 * 1024 + 512);
                const bf16x8 vf0 = __builtin_shufflevector(l0, h0, 0, 1, 2, 3, 4, 5, 6, 7), vf1 = __builtin_shufflevector(l1, h1, 0, 1, 2, 3, 4, 5, 6, 7);
                const bf16x8 pa = __builtin_bit_cast(bf16x8, pw[s2]);
                o0 = MFMA32(pa, vf0, o0); o1 = MFMA32(pa, vf1, o1); }
        }
    }
#undef A_DMA
    lsum += __shfl_xor(lsum, 32);
    LAS float* wsf = (LAS float*)(lds + A_WSF) + wid * 64;
    if (hi == 0) wsf[r32] = lsum;
    LDS_WAIT();
    LAS bf16_t* stg = (LAS bf16_t*)(lds + A_OST) + wid * 2048;
#pragma unroll
    for (int r = 0; r < 16; ++r) { const int orow = crow(r, hi); const float rl = __builtin_amdgcn_rcpf(wsf[orow]);
        stg[orow * 64 + r32] = (bf16_t)(cvtpk(o0[r] * rl, 0.f) & 0xffffu); stg[orow * 64 + 32 + r32] = (bf16_t)(cvtpk(o1[r] * rl, 0.f) & 0xffffu); }
    LDS_WAIT();
    const bf16_t* gates = (const bf16_t*)(F.ws + WS_GATES); bf16_t* mix = (bf16_t*)(F.ws + WS_MIX);
#pragma unroll
    for (int i = 0; i < 4; ++i) { const int row = i * 8 + (lane >> 3), ch = lane & 7; const u32x4 v = *(const LAS u32x4*)(stg + row * 64 + ch * 8);
        const float o[8] = {bflo(v.x), bfhi(v.x), bflo(v.y), bfhi(v.y), bflo(v.z), bfhi(v.z), bflo(v.w), bfhi(v.w)};
        merge_store8(gates, mix, rowbase + q0 + wid * 32 + row, h * 64 + ch * 8, o); }
    __syncthreads();
}

DI void attn_prompt_unit64(Frame& F, int b, int h, int qb2) {
    LAS char* lds = (LAS char*)F.lds;
    const int lane = fresh_lane(), wid = F.wave, r32 = lane & 31, hi = lane >> 5;
    const bf16_t* KN = (const bf16_t*)(F.out + O_Y); const bf16_t* V = KN + (size_t)MP * DM;
    const bf16_t* KR = (const bf16_t*)(F.ws + WS_KR);
    const size_t rowbase = (size_t)b * PT; const int q0 = qb2 * 512;
    const bf16_t* Q = q_part(F.ws, rowbase + q0);
    const int NT = (q0 + 512) / 64, cw = q0 / 64 + wid;
    const bf16_t* kng = KN + (rowbase + lane) * DM + h * 64 + wid * 8;
    const bf16_t* krg = KR + (rowbase + lane) * ROPE + (wid & 3) * 8;
    const bf16_t* vg = V + (rowbase + 16 * (wid & 3) + (lane >> 2)) * DM + h * 64 + (wid >> 2) * 32 + (lane & 3) * 8;
#define A_DMA(t) do { const int sl_ = ((t) & 3) * A_SLOT; const size_t adv_ = (size_t)(t) * 64; \
        __builtin_amdgcn_global_load_lds((const unsigned*)(kng + adv_ * DM), (LAS unsigned*)(lds + sl_ + wid * KCH), 16, 0, 0); \
        if (wid < 4) __builtin_amdgcn_global_load_lds((const unsigned*)(krg + adv_ * ROPE), (LAS unsigned*)(lds + sl_ + (8 + wid) * KCH), 16, 0, 0); \
        __builtin_amdgcn_global_load_lds((const unsigned*)(vg + adv_ * DM), (LAS unsigned*)(lds + sl_ + 12288 + wid * 1024), 16, 0, 0); } while (0)
    A_DMA(0); A_DMA(1); A_DMA(2);
    bf16x8 qf[2][6];
#pragma unroll
    for (int hf = 0; hf < 2; ++hf) { const bf16_t* qp = Q + (rowbase + q0 + wid * 64 + hf * 32 + r32) * 1536 + h * QKD + 8 * hi;
#pragma unroll
        for (int s = 0; s < 6; ++s) qf[hf][s] = *(const bf16x8*)(qp + 16 * s); }
    const f32x16 zero16 = (f32x16){0.f, 0.f, 0.f, 0.f, 0.f, 0.f, 0.f, 0.f, 0.f, 0.f, 0.f, 0.f, 0.f, 0.f, 0.f, 0.f};
    f32x16 o[2][2];
#pragma unroll
    for (int hf = 0; hf < 2; ++hf) { o[hf][0] = zero16; o[hf][1] = zero16; }
    float lsum[2] = {0.f, 0.f};
    const int vrd = ((lane >> 4) & 1) * 32 + (lane & 3) * 8 + (4 * hi + ((lane & 15) >> 2)) * 64;
    for (int t = 0; t < NT; ++t) {
        { const int rem = NT - 1 - t;
          if (rem >= 2) { if (wid < 4) VMWAIT(6); else VMWAIT(4); }
          else if (rem == 1) { if (wid < 4) VMWAIT(3); else VMWAIT(2); }
          else VMWAIT(0); }
        __builtin_amdgcn_s_barrier(); asm volatile("" ::: "memory");
        if (t + 3 < NT) A_DMA(t + 3);
        if (t <= cw) {
            const LAS char* kb = lds + (t & 3) * A_SLOT + r32 * 16;
            f32x16 p[2][2];
#pragma unroll
            for (int s = 0; s < 6; ++s) { const bf16x8 a0 = *(const LAS bf16x8*)(kb + (2 * s + hi) * KCH), a1 = *(const LAS bf16x8*)(kb + (2 * s + hi) * KCH + 512);
#pragma unroll
                for (int hf = 0; hf < 2; ++hf) { p[hf][0] = MFMA32(a0, qf[hf][s], s == 0 ? zero16 : p[hf][0]); p[hf][1] = MFMA32(a1, qf[hf][s], s == 0 ? zero16 : p[hf][1]); } }
            u32x4 pw[2][4];
#pragma unroll
            for (int hf = 0; hf < 2; ++hf) { float sacc = 0.f;
#pragma unroll
                for (int r = 0; r < 16; ++r) { p[hf][0][r] = __builtin_amdgcn_exp2f(p[hf][0][r]); p[hf][1][r] = __builtin_amdgcn_exp2f(p[hf][1][r]); sacc += p[hf][0][r] + p[hf][1][r]; }
                lsum[hf] += sacc;
#pragma unroll
                for (int e = 0; e < 4; ++e) { pw[hf][0][e] = cvtpk(p[hf][0][2 * e], p[hf][0][2 * e + 1]); pw[hf][1][e] = cvtpk(p[hf][0][8 + 2 * e], p[hf][0][8 + 2 * e + 1]);
                    pw[hf][2][e] = cvtpk(p[hf][1][2 * e], p[hf][1][2 * e + 1]); pw[hf][3][e] = cvtpk(p[hf][1][8 + 2 * e], p[hf][1][8 + 2 * e + 1]); } }
            const LAS char* vb = lds + (t & 3) * A_SLOT + 12288 + vrd;
#pragma unroll
            for (int s2 = 0; s2 < 4; ++s2) {
                const s16x4 l0 = vtr(vb + s2 * 1024), h0 = vtr(vb + s2 * 1024 + 512), l1 = vtr(vb + 4096 + s2 * 1024), h1 = vtr(vb + 4096 + s2 * 1024 + 512);
                const bf16x8 vf0 = __builtin_shufflevector(l0, h0, 0, 1, 2, 3, 4, 5, 6, 7), vf1 = __builtin_shufflevector(l1, h1, 0, 1, 2, 3, 4, 5, 6, 7);
#pragma unroll
                for (int hf = 0; hf < 2; ++hf) { const bf16x8 pa = __builtin_bit_cast(bf16x8, pw[hf][s2]); o[hf][0] = MFMA32(pa, vf0, o[hf][0]); o[hf][1] = MFMA32(pa, vf1, o[hf][1]); } }
        }
    }
#undef A_DMA
    const bf16_t* gates = (const bf16_t*)(F.ws + WS_GATES); bf16_t* mix = (bf16_t*)(F.ws + WS_MIX);
    LAS float* wsf = (LAS float*)(lds + A_WSF) + wid * 64;
    LAS bf16_t* stg = (LAS bf16_t*)(lds + A_OST) + wid * 2048;
#pragma unroll
    for (int hf = 0; hf < 2; ++hf) {
        float l = lsum[hf]; l += __shfl_xor(l, 32);
        if (hi == 0) wsf[r32] = l;
        LDS_WAIT();
#pragma unroll
        for (int r = 0; r < 16; ++r) { const int orow = crow(r, hi); const float rl = __builtin_amdgcn_rcpf(wsf[orow]);
            stg[orow * 64 + r32] = (bf16_t)(cvtpk(o[hf][0][r] * rl, 0.f) & 0xffffu); stg[orow * 64 + 32 + r32] = (bf16_t)(cvtpk(o[hf][1][r] * rl, 0.f) & 0xffffu); }
        LDS_WAIT();
#pragma unroll
        for (int i = 0; i < 4; ++i) { const int row = i * 8 + (lane >> 3), ch = lane & 7; const u32x4 v = *(const LAS u32x4*)(stg + row * 64 + ch * 8);
            const float ov[8] = {bflo(v.x), bfhi(v.x), bflo(v.y), bfhi(v.y), bflo(v.z), bfhi(v.z), bflo(v.w), bfhi(v.w)};
            merge_store8(gates, mix, rowbase + q0 + wid * 64 + hf * 32 + row, h * 64 + ch * 8, ov); }
        LDS_WAIT();
    }
    __syncthreads();
}

constexpr int S_WLD = 272;
constexpr int S_W0 = 0, S_OBUF = 128 * S_WLD  , S_LBUF = S_OBUF + 8 * 8192, S_END = S_LBUF + 8 * 128;
DI void attn_sample_unit(Frame& F, int b, int h, float negb) {
    LAS char* lds = (LAS char*)F.lds;
    const int lane = fresh_lane(), wid = F.wave, tid = wid * 64 + lane, r32 = lane & 31, hi = lane >> 5;
    const bf16_t* Q = q_part(F.ws, (size_t)MP); const bf16_t* LAT = (const bf16_t*)(F.ws + WS_LAT); const bf16_t* KR = (const bf16_t*)(F.ws + WS_KR);
    const bf16_t* WN = (const bf16_t*)(F.ws + WS_WKVN) + (size_t)h * 128 * 128;
    for (int i = tid; i < 128 * 16; i += NTHREADS) { const int r = i >> 4, c = i & 15; *(LAS u32x4*)(lds + S_W0 + r * S_WLD + c * 16) = *(const u32x4*)(WN + r * 128 + c * 8); }
    const bf16_t* qp = Q + ((size_t)MP + b * ST + r32) * 1536 + h * QKD;
    const float* gkn = F.in(15);
    bf16x8 qn[4], qr[2];
#pragma unroll
    for (int s = 0; s < 4; ++s) { const u32x2 a = *(const u32x2*)(qp + 16 * s + 4 * hi), c = *(const u32x2*)(qp + 16 * s + 8 + 4 * hi);
        const f32x4 ga = *(const f32x4*)(gkn + 16 * s + 4 * hi), gc = *(const f32x4*)(gkn + 16 * s + 8 + 4 * hi);
        u32x4 w; w.x = cvtpk(bflo(a.x) * ga[0], bfhi(a.x) * ga[1]); w.y = cvtpk(bflo(a.y) * ga[2], bfhi(a.y) * ga[3]); w.z = cvtpk(bflo(c.x) * gc[0], bfhi(c.x) * gc[1]); w.w = cvtpk(bflo(c.y) * gc[2], bfhi(c.y) * gc[3]);
        qn[s] = __builtin_bit_cast(bf16x8, w); }
#pragma unroll
    for (int s = 0; s < 2; ++s) qr[s] = *(const bf16x8*)(qp + 64 + 16 * s + 8 * hi);
    f32x16 o0, o1;
#pragma unroll
    for (int r = 0; r < 16; ++r) { o0[r] = 0.f; o1[r] = 0.f; }
    float lsum = 0.f;
    f32x16 negm;
#pragma unroll
    for (int r = 0; r < 16; ++r) negm[r] = negb;
    __syncthreads();
    const size_t lrow0 = (size_t)MP + (size_t)b * SKEYS;
    const LAS char* wk = lds + S_W0 + r32 * S_WLD + 16 * hi;
    const LAS char* wv = lds + S_W0 + (64 + r32) * S_WLD + 16 * hi;
#define FENCE() asm volatile("" ::: "memory")
    for (int kb = wid; kb < (SKEYS + 31) / 32; kb += NWAVES) {
        const size_t row = lrow0 + (size_t)kb * 32 + r32;
        bf16x8 lf[8], rf[2];
#pragma unroll
        for (int s = 0; s < 8; ++s) lf[s] = *(const bf16x8*)(LAT + row * KVL + 16 * s + 8 * hi);
#pragma unroll
        for (int s = 0; s < 2; ++s) rf[s] = *(const bf16x8*)(KR + row * ROPE + 16 * s + 8 * hi);
        f32x16 kt0 = (f32x16){0.f, 0.f, 0.f, 0.f, 0.f, 0.f, 0.f, 0.f, 0.f, 0.f, 0.f, 0.f, 0.f, 0.f, 0.f, 0.f}, kt1 = kt0;
        { bf16x8 wq0[3], wq1[3];
          wq0[0] = *(const LAS bf16x8*)(wk); wq1[0] = *(const LAS bf16x8*)(wk + 32 * S_WLD); wq0[1] = *(const LAS bf16x8*)(wk + 32); wq1[1] = *(const LAS bf16x8*)(wk + 32 * S_WLD + 32);
#pragma unroll
          for (int s = 0; s < 8; ++s) {
            if (s + 2 < 8) { wq0[(s + 2) % 3] = *(const LAS bf16x8*)(wk + (s + 2) * 32); wq1[(s + 2) % 3] = *(const LAS bf16x8*)(wk + 32 * S_WLD + (s + 2) * 32); }
            kt0 = MFMA32(wq0[s % 3], lf[s], kt0); kt1 = MFMA32(wq1[s % 3], lf[s], kt1);
            FENCE(); } }
        float ss = 0.f;
#pragma unroll
        for (int r = 0; r < 16; ++r) ss += kt0[r] * kt0[r] + kt1[r] * kt1[r];
        ss = xsum32(ss);
        const float rk = __builtin_amdgcn_rsqf(ss * (1.0f / 64.0f) + EPS);
        bf16x8 kf[4];
#pragma unroll
        for (int s = 0; s < 4; ++s) { u32x4 w;
#pragma unroll
            for (int e = 0; e < 4; ++e) { const int r = 8 * (s & 1) + 2 * e; w[e] = (s < 2) ? cvtpk(kt0[r] * rk, kt0[r + 1] * rk) : cvtpk(kt1[r] * rk, kt1[r + 1] * rk); }
            kf[s] = __builtin_bit_cast(bf16x8, w); }
        f32x16 p = negm;
#pragma unroll
        for (int s = 0; s < 4; ++s) p = MFMA32(kf[s], qn[s], p);
        p = MFMA32(rf[0], qr[0], p); p = MFMA32(rf[1], qr[1], p);
        const bool full = (kb * 32 + 32) <= SKEYS;
        float sacc = 0.f;
#pragma unroll
        for (int r = 0; r < 16; ++r) { float e = __builtin_amdgcn_exp2f(p[r]); if (!full && (kb * 32 + crow(r, hi)) >= SKEYS) e = 0.f; p[r] = e; sacc += e; }
        lsum += sacc;
        bf16x8 pf[2];
#pragma unroll
        for (int s2 = 0; s2 < 2; ++s2) { u32x4 pw;
#pragma unroll
            for (int e = 0; e < 4; ++e) { const int r = 8 * s2 + 2 * e; pw[e] = cvtpk(p[r], p[r + 1]); }
            pf[s2] = __builtin_bit_cast(bf16x8, pw); }
        FENCE();
        f32x16 v0 = (f32x16){0.f, 0.f, 0.f, 0.f, 0.f, 0.f, 0.f, 0.f, 0.f, 0.f, 0.f, 0.f, 0.f, 0.f, 0.f, 0.f}, v1 = v0;
        { bf16x8 wq0[3], wq1[3];
          wq0[0] = *(const LAS bf16x8*)(wv); wq1[0] = *(const LAS bf16x8*)(wv + 32 * S_WLD); wq0[1] = *(const LAS bf16x8*)(wv + 32); wq1[1] = *(const LAS bf16x8*)(wv + 32 * S_WLD + 32);
#pragma unroll
          for (int s = 0; s < 8; ++s) {
            if (s + 2 < 8) { wq0[(s + 2) % 3] = *(const LAS bf16x8*)(wv + (s + 2) * 32); wq1[(s + 2) % 3] = *(const LAS bf16x8*)(wv + 32 * S_WLD + (s + 2) * 32); }
            v0 = MFMA32(lf[s], wq0[s % 3], v0); v1 = MFMA32(lf[s], wq1[s % 3], v1);
            FENCE(); } }
#pragma unroll
        for (int s2 = 0; s2 < 2; ++s2) { u32x4 vw0, vw1;
#pragma unroll
            for (int e = 0; e < 4; ++e) { const int r = 8 * s2 + 2 * e; vw0[e] = cvtpk(v0[r], v0[r + 1]); vw1[e] = cvtpk(v1[r], v1[r + 1]); }
            o0 = MFMA32(pf[s2], __builtin_bit_cast(bf16x8, vw0), o0); o1 = MFMA32(pf[s2], __builtin_bit_cast(bf16x8, vw1), o1); }
        FENCE();
    }
    lsum += __shfl_xor(lsum, 32);
    LAS float* ob = (LAS float*)(lds + S_OBUF) + wid * 2048; LAS float* lb = (LAS float*)(lds + S_LBUF) + wid * 32;
    if (hi == 0) lb[r32] = lsum;
#pragma unroll
    for (int r = 0; r < 16; ++r) { const int q = crow(r, hi); ob[q * 64 + r32] = o0[r]; ob[q * 64 + 32 + r32] = o1[r]; }
    __syncthreads();
    if (tid < 256) { const int q = tid >> 3, c8 = (tid & 7) * 8; float o[8], l = 0.f;
#pragma unroll
        for (int i = 0; i < 8; ++i) o[i] = 0.f;
#pragma unroll
        for (int w = 0; w < 8; ++w) { const LAS float* p = (const LAS float*)(lds + S_OBUF) + w * 2048 + q * 64 + c8; const f32x4 a = *(const LAS f32x4*)p, c = *(const LAS f32x4*)(p + 4);
            o[0] += a[0]; o[1] += a[1]; o[2] += a[2]; o[3] += a[3]; o[4] += c[0]; o[5] += c[1]; o[6] += c[2]; o[7] += c[3]; l += ((const LAS float*)(lds + S_LBUF))[w * 32 + q]; }
        const float rl = 1.0f / l;
#pragma unroll
        for (int i = 0; i < 8; ++i) o[i] *= rl;
        merge_store8((const bf16_t*)(F.ws + WS_GATES), (bf16_t*)(F.ws + WS_MIX), (size_t)MP + b * ST + q, h * 64 + c8, o); }
    __syncthreads();
}

DI void p7_attention(Frame& F) {
    const float negb = attn_negb(F);
#ifndef NO_SAMPLE
    for (int u0 = F.bid; u0 < SB * NH; u0 += F.G) { const int u = (F.G == 256) ? (u0 & 7) * 32 + (u0 >> 3) : u0; attn_sample_unit(F, u >> 4, u & 15, negb); }
#endif
#ifndef NO_PROMPT
    if (F.G == 256 && negb > -96.0f) {
        const int g = F.bid >> 6, bh = F.bid & 63;
        attn_prompt_unit64(F, bh >> 4, bh & 15, 7 - g); attn_prompt_unit64(F, bh >> 4, bh & 15, g);
    } else {
        for (int L = F.bid; L < PB * NH * 16; L += F.G) attn_prompt_unit(F, (L & 63) >> 4, L & 15, 15 - (L >> 6), negb);
    }
#endif
}


#define XB_TMO      128
#define XB_XCNT(j)  (256  + 64 * (j))
#define XB_XSUB(j)  (1280 + 64 * (j))
#define XB_XGEN(j)  (2304 + 64 * (j))
#define XB_TOP      3328
#define XB_TOPGEN   3392
#define XCD_BAR_WORDS 3456
#define XB_SPIN_CAP (1u << 22)
DI unsigned xb_ld(unsigned* p)              { return __hip_atomic_load(p, __ATOMIC_RELAXED, __HIP_MEMORY_SCOPE_AGENT); }
DI unsigned xb_add(unsigned* p, unsigned v) { return __hip_atomic_fetch_add(p, v, __ATOMIC_RELAXED, __HIP_MEMORY_SCOPE_AGENT); }
DI unsigned xb_xcc_id() { return (unsigned)__builtin_amdgcn_s_getreg((3 << 11) | 20) & 0xFu; }
#define XB_SPIN(cond, bar) do { unsigned _sp = 0; while (cond) { __builtin_amdgcn_s_sleep(1); \
    if ((++_sp & 255u) == 0u) { if (xb_ld(&(bar)[XB_TMO])) break; if (_sp > XB_SPIN_CAP) { atomicAdd(&(bar)[XB_TMO], 1u); break; } } } } while (0)
struct XcdBarrier { unsigned* bar; unsigned x; volatile LAS unsigned* st; };
DI XcdBarrier xcd_barrier_post(unsigned* bar, volatile LAS unsigned* st, bool leader) {
    XcdBarrier b; b.bar = bar; b.x = xb_xcc_id(); b.st = st;
    if (leader) (void)xb_add(&bar[XB_XCNT(b.x)], 1u);
    return b;
}
DI void xcd_barrier_complete(unsigned* bar, unsigned x, unsigned G, unsigned& nloc, unsigned& nx) {
    unsigned sum, cnt, mine, sp = 0u;
    for (;;) {
        sum = 0u; cnt = 0u; mine = 0u;
#pragma unroll
        for (unsigned j = 0; j < 16; ++j) { const unsigned c = xb_ld(&bar[XB_XCNT(j)]); sum += c; cnt += (c > 0u) ? 1u : 0u; mine = (j == x) ? c : mine; }
        if (sum == G) break;
        __builtin_amdgcn_s_sleep(1);
        if ((++sp & 255u) == 0u) { if (xb_ld(&bar[XB_TMO])) break; if (sp > XB_SPIN_CAP) { atomicAdd(&bar[XB_TMO], 1u); break; } }
    }
    nloc = mine > 0u ? mine : 1u; nx = cnt > 0u ? cnt : 1u;
}
DI void xcd_barrier(const XcdBarrier& b, unsigned G, int wave) {
    asm volatile("s_waitcnt vmcnt(0)" ::: "memory");
    __syncthreads();
    if (wave == 0 && fresh_lane() == 0) {
        unsigned* bar = b.bar;
        __builtin_amdgcn_s_waitcnt(0);
        unsigned nloc = b.st[0], nx = b.st[1];
        if (nloc == 0u) { xcd_barrier_complete(bar, b.x, G, nloc, nx); b.st[0] = nloc; b.st[1] = nx; }
        const unsigned old = xb_add(&bar[XB_XSUB(b.x)], 1u);
        const unsigned gen = old / nloc;
        if (old + 1u == (gen + 1u) * nloc) {
            __builtin_amdgcn_fence(__ATOMIC_RELEASE, "agent");
            asm volatile("s_waitcnt vmcnt(0)" ::: "memory");
            const unsigned og = xb_add(&bar[XB_TOP], 1u);
            const unsigned tg = og / nx;
            if (og + 1u == (tg + 1u) * nx) xb_add(&bar[XB_TOPGEN], 1u);
            else XB_SPIN(xb_ld(&bar[XB_TOPGEN]) == tg, bar);
            __builtin_amdgcn_fence(__ATOMIC_ACQUIRE, "agent");
            xb_add(&bar[XB_XGEN(b.x)], 1u);
            asm volatile("s_waitcnt vmcnt(0)" ::: "memory");
        } else {
            XB_SPIN(xb_ld(&bar[XB_XGEN(b.x)]) == gen, bar);
            __builtin_amdgcn_fence(__ATOMIC_ACQUIRE, "agent");
            asm volatile("s_waitcnt vmcnt(0)" ::: "memory");
        }
    }
    __syncthreads();
}

__global__ void __launch_bounds__(NTHREADS, 2) hybrid_fwd(Args args) {
    extern __shared__ __attribute__((aligned(16))) unsigned char lds_raw[];
    Frame F;
    F.lds = (LAS unsigned char*)lds_raw; F.wave = __builtin_amdgcn_readfirstlane(threadIdx.x >> 6);
    F.G = gridDim.x; F.bid = blockIdx.x; F.ws = args.ws; F.out = args.out;
    unsigned char* ws = args.ws;
    if (threadIdx.x < 30) ((LAS unsigned long long*)(F.lds + RING_BYTES))[threadIdx.x] = (unsigned long long)args.in[threadIdx.x];
    __syncthreads();
    const int lo = args.ph_lo, hi = args.ph_hi;
    if (threadIdx.x < 8) ((LAS unsigned*)(F.lds + RING_BYTES + 256))[threadIdx.x] = 0u;
    __syncthreads();
    const XcdBarrier bar = xcd_barrier_post((unsigned*)(ws + WS_CTL) + 1024, (volatile LAS unsigned*)(F.lds + RING_BYTES + 256), threadIdx.x == 0);
#ifndef PH_MASK
#define PH_MASK 0xFFFF
#endif
#define IN(k) (((PH_MASK >> (k)) & 1) && lo <= (k) && (k) < hi)
#define SEAM(k) do { if (IN(k) && IN((k) + 1)) xcd_barrier(bar, (unsigned)gridDim.x, F.wave); } while (0)
    const int bid = (int)blockIdx.x, G = (int)gridDim.x;

    if (IN(0)) { p0_prologue(F); } SEAM(0);
    if (IN(1)) {
        pg8::Gemm g{(const bf16_t*)(ws + WS_XN), (const bf16_t*)(ws + WS_WIN), 1024, 1024, 1024, 0, 1, 0, MT / 256, 14};
        pg8::StaticOrder S; S.init(g.nM, g.nN, G, bid);
        EpiIn E{(bf16_t*)(ws + WS_CQN), (float*)(ws + WS_SSCQ), (bf16_t*)(args.out + O_Y), (bf16_t*)(ws + WS_GATES), F.in(11), F.in(16), (const f32x2*)(ws + WS_TAB), args.out, (bf16_t*)(ws + WS_LAT), (bf16_t*)(ws + WS_KR)};
        pg8::gemm_phase<0>(F.lds, F.wave, g, S, E);
        { const int first = (g.nM * g.nN) % G;
          if (first != 0 && bid >= first) { late_weights(F, (bid - first) * NWAVES + F.wave, (G - first) * NWAVES, 0, G == 256 ? LATE_DOWN0 : LATE_ITEMS);
              if (G == 256) cache_convert(F, (bid - first) * NTHREADS + F.wave * 64 + fresh_lane(), (G - first) * NTHREADS, CACHE_P0, SB - CACHE_LATE); }
          else if (first == 0) late_weights(F, bid * NWAVES + F.wave, G * NWAVES, 0, LATE_ITEMS); }
    } SEAM(1);
    if (IN(2)) {
        pg8::Gemm g{(const bf16_t*)(ws + WS_UC), (const bf16_t*)(ws + WS_WLRU), 1024, 128, 128, 128, 1, 0, MP / 256, 8};
        pg8::StaticOrder S; S.init(g.nM, g.nN, G, bid);
        EpiLru E{(const bf16_t*)(ws + WS_UC), F.in(20), F.in(22), (const float*)(ws + WS_SP8), (bf16_t*)(ws + WS_LA), (bf16_t*)(ws + WS_BT)};
        conv_own_units(F, S);
        pg8::gemm_phase<0>(F.lds, F.wave, g, S, E);
        scan_local_own(F, S);
        lru_small(F);
    } SEAM(2);
    if (IN(3)) {
        p5_scan_apply(F);
        { pg8::Gemm g{(const bf16_t*)(ws + WS_CQN), (const bf16_t*)(ws + WS_WQB), 256, 256, 256, 0, 1, 0, MT / 256, 6};
          pg8::StaticOrder S; S.init(g.nM, g.nN, G, bid);
          EpiQ E{ws, F.in(13), F.in(14), (const f32x2*)(ws + WS_TAB), (const float*)(ws + WS_SSCQ)};
          pg8::gemm_phase<0>(F.lds, F.wave, g, S, E); }
        { pg8::Gemm g{(const bf16_t*)(ws + WS_LAT), (const bf16_t*)(ws + WS_WKVB), 128, 128, 128, 0, 1, 0, MP / 256, 8};
          pg8::StaticOrder S; S.init(g.nM, g.nN, G, (bid + 144) % G);
          EpiKV E{(bf16_t*)(args.out + O_Y), (bf16_t*)(args.out + O_Y) + (size_t)MP * DM, F.in(15)};
          pg8::gemm_phase<0>(F.lds, F.wave, g, S, E); }
        if (G == 256 && bid >= SCAN_EXTRA0 + 16) { constexpr int LIGHT0 = SCAN_EXTRA0 + 16; cache_convert(F, (bid - LIGHT0) * NTHREADS + F.wave * 64 + fresh_lane(), (256 - LIGHT0) * NTHREADS, SB - CACHE_LATE, SB); }
    } SEAM(3);
    if (IN(4)) { p7_attention(F); } SEAM(4);
    if (IN(5)) {
        { pg8::Gemm g{(const bf16_t*)(ws + WS_MIX), (const bf16_t*)(ws + WS_WOUT), 1024, 1024, 1024, 0, 1, 0, MP / 256, 4};
          pg8::StaticOrder S; S.init(g.nM, g.nN, G, bid);
          EpiOut E{F.in(0), (bf16_t*)(ws + WS_XMB), (float*)(ws + WS_SSROW)};
          pg8::gemm_phase<0>(F.lds, F.wave, g, S, E); }
        { FinOut fin{F.in(1), (bf16_t*)(ws + WS_XMB), (float*)(ws + WS_SSROW)};
          small_gemm<DM / 128>(F, (const bf16_t*)(ws + WS_MIX) + (size_t)MP * DM, DM, (const bf16_t*)(ws + WS_WOUT), DM, fin); }
    } SEAM(5);
    if (IN(6)) {
        static_assert(EpiUp<true>::N_FAST + EpiUp<true>::N_SLOW == (MT + 247) / 248, "row tiles of the up projection");
        { pg8::Gemm g{(const bf16_t*)(ws + WS_XMB) + 2 * DM, (const bf16_t*)(ws + WS_WUP), 1024, 1024, 1024, 0, 1, 0, EpiUp<true>::N_FAST, 22};
          pg8::StaticOrder S; S.init(g.nM, g.nN, G, bid);
          EpiUp<true> E{(const float*)(ws + WS_SSROW), (const float*)(ws + WS_CWS), F.in(6), (bf16_t*)(ws + WS_HFF), args.out + O_PFFN, args.out + O_SFFN};
          pg8::gemm_phase<2>(F.lds, F.wave, g, S, E); }
        { pg8::Gemm g{(const bf16_t*)(ws + WS_XMB) + 2 * DM, (const bf16_t*)(ws + WS_WUP), 1024, 1024, 1024, 0, 1, 0, EpiUp<false>::N_SLOW, 22};
          const int first = (EpiUp<true>::N_FAST * 22) % G;
          pg8::StaticOrder S; S.init(g.nM, g.nN, G, (bid - first + G) % G);
          EpiUp<false> E{(const float*)(ws + WS_SSROW), (const float*)(ws + WS_CWS), F.in(6), (bf16_t*)(ws + WS_HFF), args.out + O_PFFN, args.out + O_SFFN};
          pg8::gemm_phase<2>(F.lds, F.wave, g, S, E);
          constexpr int NSLOW = EpiUp<false>::N_SLOW * 22;
          if (G == 256) { const int c = (bid - first + G) % G; if (c >= NSLOW && bid >= first) late_weights(F, (c - NSLOW) * NWAVES + F.wave, (G - first - NSLOW) * NWAVES, LATE_DOWN0, LATE_ITEMS); } }
    } SEAM(6);
    if (IN(7)) {
        { pg8::Gemm g{(const bf16_t*)(ws + WS_HFF), (const bf16_t*)(ws + WS_WDOWN), DFF, DFF, DFF, 0, 1, 0, MP / 256, 4};
          pg8::StaticOrder S; S.init(g.nM, g.nN, G, bid);
          EpiDown E{(const bf16_t*)(ws + WS_XMB), args.out + O_Y};
          pg8::gemm_phase<0>(F.lds, F.wave, g, S, E); }
        { FinDown fin{(const bf16_t*)(ws + WS_XMB), args.out + O_Y};
          small_gemm<DFF / 128>(F, (const bf16_t*)(ws + WS_HFF) + (size_t)MP * DFF, DFF, (const bf16_t*)(ws + WS_WDOWN), DFF, fin); }
    }
#undef IN
#undef SEAM
}

extern "C" void kernel_launch(void* const* d_in, const int* in_sizes, int n_in, void* d_out, int out_size, void* d_ws, size_t ws_size, hipStream_t stream) {
    static int grid = 0;
    if (grid == 0) {
        if (n_in != 30 || out_size != (int)O_END || ws_size < WS_END) { fprintf(stderr, "kernel_launch: unexpected problem (n_in %d out %d ws %zu)\n", n_in, out_size, ws_size); grid = -1; return; }
        int dev = 0, cus = 0, per_cu = 0;
        hipGetDevice(&dev); hipDeviceGetAttribute(&cus, hipDeviceAttributeMultiprocessorCount, dev);
        if (hipFuncSetAttribute((const void*)hybrid_fwd, hipFuncAttributeMaxDynamicSharedMemorySize, LDS_BYTES) != hipSuccess) { fprintf(stderr, "kernel_launch: hipFuncSetAttribute failed\n"); grid = -1; return; }
        if (hipOccupancyMaxActiveBlocksPerMultiprocessor(&per_cu, (const void*)hybrid_fwd, NTHREADS, LDS_BYTES) != hipSuccess || per_cu < 1) { fprintf(stderr, "kernel_launch: occupancy query says %d\n", per_cu); per_cu = 1; }
        (void)hipGetLastError();
        grid = cus;
    }
    if (grid < 0) return;
    if (hipMemsetAsync((char*)d_ws + WS_CTL, 0, CTL_BYTES, stream) != hipSuccess) { fprintf(stderr, "kernel_launch: memset failed\n"); return; }
    Args a{};
    for (int i = 0; i < 30; ++i) a.in[i] = (const float*)d_in[i];
    a.out = (float*)d_out; a.ws = (unsigned char*)d_ws;
#if MK_LAUNCHES == 1
    a.ph_lo = 0; a.ph_hi = N_PHASES;
    void* kargs[] = {&a};
    hipError_t e = hipLaunchCooperativeKernel((const void*)hybrid_fwd, dim3(grid), dim3(NTHREADS), kargs, LDS_BYTES, stream);
    if (e != hipSuccess) fprintf(stderr, "kernel_launch: cooperative launch failed: %s (grid %d)\n", hipGetErrorString(e), grid);
#else
    for (int p = 0; p < N_PHASES; ++p) { a.ph_lo = p; a.ph_hi = p + 1; hipLaunchKernelGGL(hybrid_fwd, dim3(grid), dim3(NTHREADS), LDS_BYTES, stream, a); }
#endif
}
```

```cpp
#include <hip/hip_runtime.h>
#include <cstdio>
#include <cstdint>

#ifndef MK_LAUNCHES
#define MK_LAUNCHES 1
#endif

#define LAS __attribute__((address_space(3)))
#define DI __device__ __forceinline__
typedef unsigned short bf16_t;
typedef short bf16x8 __attribute__((ext_vector_type(8)));
typedef short s16x4 __attribute__((ext_vector_type(4)));
typedef float f32x4 __attribute__((ext_vector_type(4)));
typedef float f32x2 __attribute__((ext_vector_type(2)));
typedef float f32x16 __attribute__((ext_vector_type(16)));
typedef unsigned u32x4 __attribute__((ext_vector_type(4)));
typedef unsigned u32x2 __attribute__((ext_vector_type(2)));
typedef __bf16 bf16x2_t __attribute__((ext_vector_type(2)));

constexpr int DM = 1024, PB = 4, PT = 4096, SB = 16, ST = 32, PAST = 4096;
constexpr int MP = PB * PT, MS = SB * ST, MT = MP + MS;
constexpr int NH = 16, QL = 256, KVL = 128, NOPE = 64, ROPE = 32, QKD = 96;
constexpr int DFF = 2816, NUP = 2 * DFF;
constexpr int SKEYS = PAST + ST;
constexpr int LROWS = MP + SB * SKEYS;
constexpr float EPS = 1e-6f;
constexpr float LOG2E = 1.4426950408889634f;
constexpr float QSCALE = 0.10206207261596577f * LOG2E;
constexpr int ZQW = 416;

constexpr size_t MiB = 1u << 20;
constexpr size_t WS_CTL = 0, CTL_BYTES = 64 * 1024;
constexpr size_t WS_TAB = 1 * MiB;
constexpr size_t WS_SP8 = 1 * MiB + 768 * 1024;
constexpr size_t WS_SSCQ = 1 * MiB + 896 * 1024;
constexpr size_t WS_SSROW = 2 * MiB;
constexpr size_t WS_CWS = 3 * MiB;
constexpr size_t WS_AGG = 4 * MiB;
constexpr size_t WS_WIN = 6 * MiB;
constexpr size_t WS_WQB = 13 * MiB;
constexpr size_t WS_WKVB = 13 * MiB + 768 * 1024;
constexpr size_t WS_WKVN = 14 * MiB + 256 * 1024;
constexpr size_t WS_WLRU = 14 * MiB + 768 * 1024;
constexpr size_t WS_WOUT = 15 * MiB + 512 * 1024;
constexpr size_t WS_WUP = 17 * MiB + 512 * 1024;
constexpr size_t WS_WDOWN = 28 * MiB + 512 * 1024;
constexpr size_t WS_LAT = 34 * MiB;
constexpr size_t WS_KR = 54 * MiB + 512 * 1024;
constexpr size_t WS_GATES = 60 * MiB;
constexpr size_t WS_XN = 126 * MiB;
constexpr size_t WS_ZQ = 159 * MiB;
constexpr size_t WS_CQN = 228 * MiB;
constexpr size_t WS_UC = 126 * MiB;
constexpr size_t WS_LA = 159 * MiB;
constexpr size_t WS_BT = 192 * MiB;
constexpr size_t WS_Q1 = 126 * MiB;
constexpr size_t WS_Q2 = 237 * MiB;
constexpr int QSPLIT = 11264;
constexpr size_t WS_MIX = 192 * MiB;
constexpr size_t WS_XMB = 126 * MiB;
constexpr size_t WS_HFF = 160 * MiB;
constexpr size_t WS_END = 254 * MiB;
constexpr int XMB_ROWS = 17152;

constexpr size_t O_Y = 0;
constexpr size_t O_PLAT = (size_t)MT * DM;
constexpr size_t O_PKR = O_PLAT + (size_t)MP * KVL;
constexpr size_t O_PH = O_PKR + (size_t)MP * ROPE;
constexpr size_t O_PCONV = O_PH + (size_t)PB * DM;
constexpr size_t O_PFFN = O_PCONV + (size_t)PB * 3 * DM;
constexpr size_t O_SLAT = O_PFFN + (size_t)PB * 2 * NUP;
constexpr size_t O_SKR = O_SLAT + (size_t)MS * KVL;
constexpr size_t O_SH = O_SKR + (size_t)MS * ROPE;
constexpr size_t O_SCONV = O_SH + (size_t)SB * DM;
constexpr size_t O_SFFN = O_SCONV + (size_t)SB * 3 * DM;
constexpr size_t O_END = O_SFFN + (size_t)SB * 2 * NUP;
static_assert(O_END == 20312064, "output size");

DI unsigned cvtpk(float lo, float hi) { f32x2 v = {lo, hi}; bf16x2_t b = __builtin_convertvector(v, bf16x2_t); return __builtin_bit_cast(unsigned, b); }
DI float bf2f(unsigned short b) { return __uint_as_float((unsigned)b << 16); }
DI float bflo(unsigned w) { return __uint_as_float(w << 16); }
DI float bfhi(unsigned w) { return __uint_as_float(w & 0xffff0000u); }
DI float wave_sum(float v) {
#pragma unroll
    for (int o = 1; o < 64; o <<= 1) v += __shfl_xor(v, o);
    return v;
}
DI int fresh_lane() { int l; asm volatile("v_mbcnt_lo_u32_b32 %0, -1, 0\n\tv_mbcnt_hi_u32_b32 %0, -1, %0" : "=v"(l)); return l; }
DI float bperm(int byteaddr, float v) { return __int_as_float(__builtin_amdgcn_ds_bpermute(byteaddr, __float_as_int(v))); }
template <int CTRL> DI float dpp_mov(float v) { return __int_as_float(__builtin_amdgcn_update_dpp(0, __float_as_int(v), CTRL, 0xf, 0xf, false)); }
DI float sigmoidf_(float x) { return __builtin_amdgcn_rcpf(1.0f + __expf(-x)); }
DI float xsum32(float x) { const auto r = __builtin_amdgcn_permlane32_swap(__float_as_uint(x), __float_as_uint(x), false, false); return __uint_as_float(r[0]) + __uint_as_float(r[1]); }
DI float xsum16(float x) { const auto r = __builtin_amdgcn_permlane16_swap(__float_as_uint(x), __float_as_uint(x), false, false); return __uint_as_float(r[0]) + __uint_as_float(r[1]); }
DI float rowsum4(float x) { return xsum32(xsum16(x)); }
#define SG2(x) __builtin_amdgcn_rcpf(1.0f + __builtin_amdgcn_exp2f(x))
DI bf16_t* q_part(unsigned char* ws, size_t row) { return row < (size_t)QSPLIT ? (bf16_t*)(ws + WS_Q1) : (bf16_t*)(ws + WS_Q2) - (size_t)QSPLIT * 1536; }
DI int row_pos(int m) { return m < MP ? (m & (PT - 1)) : PAST + ((m - MP) & (ST - 1)); }
DI int lat_row(int m) { if (m < MP) return m; const int ms = m - MP; return MP + (ms >> 5) * SKEYS + PAST + (ms & 31); }
#define LDS_WAIT() asm volatile("s_waitcnt lgkmcnt(0)" ::: "memory")
DI int crow(int r, int hi) { return (r & 3) + 8 * (r >> 2) + 4 * hi; }
#define MFMA32(a, b, c) __builtin_amdgcn_mfma_f32_32x32x16_bf16((a), (b), (c), 0, 0, 0)

namespace pg8 {
constexpr int BM = 256, BK = 64, HALF = 128, HTB = HALF * BK * 2, STAGE_BYTES = 8 * HTB, NXCD = 8, WGM = 8;
__host__ __device__ __forceinline__ int lds_byte(int r, int c) { const int st = (r >> 4) * 2 + (c >> 5), rr = r & 15, cc = c & 31, ob = rr * 64 + cc * 2; return st * 1024 + (ob ^ (((ob >> 9) & 1) << 5)); }
__host__ __device__ __forceinline__ void stage_rc(int b, int& R, int& C) { const int st = b / 1024, sb = b % 1024, swz = sb ^ (((sb >> 9) & 1) << 5); R = (st >> 1) * 16 + swz / 64; C = (st & 1) * 32 + (swz % 64) / 2; }

struct Unit { int pm, pn; };
struct Gemm { const bf16_t* A; const bf16_t* Bt; int lda, ldb, K, acoln, ks, kcol, nM, nN; };

struct StaticOrder {
    int nM, nN, nwg, G, c;
    DI void init(int nM_, int nN_, int G_, int c_) { nM = nM_; nN = nN_; nwg = nM * nN; G = G_; c = c_; }
    DI bool next(int i, Unit& u) const {
        const long L = (long)i * G + c; if (L >= nwg) return false;
        int wgid = (int)L; { const int q = nwg / NXCD, r = nwg % NXCD, xcd = wgid % NXCD, off = wgid / NXCD; wgid = (xcd < r ? xcd * (q + 1) : r * (q + 1) + (xcd - r) * q) + off; }
        const int nig = WGM * nN, gid = wgid / nig, fm = gid * WGM, gsz = (nM - fm) < WGM ? (nM - fm) : WGM;
        u.pm = fm + ((wgid % nig) % gsz); u.pn = (wgid % nig) / gsz; return true;
    }
};

template <class Epi> struct RowPerm { static constexpr bool v = false; };
template <int OV, class Epi>
DI void gemm_phase(LAS unsigned char* lds, const int wid, const Gemm g, const StaticOrder& S, const Epi& E) {
    const int wr = wid >> 2, wc = wid & 3;
    int K = g.K; asm volatile("" : "+s"(K));
    const int nt = K / BK;
    unsigned voffA[2], voffB[2]; int aoff, boff;
#define PG8_LANE_STATE() do { const int lane_ = fresh_lane(), tid_ = wid * 64 + lane_, fr_ = lane_ & 15, fq_ = lane_ >> 4; \
        _Pragma("unroll") for (int i = 0; i < 2; ++i) { int R, C; stage_rc(tid_ * 16 + i * 8192, R, C); \
            const int Ra_ = RowPerm<Epi>::v ? ((R & ~63) | (4 * (R & 15) + ((R >> 4) & 3))) : R; \
            voffA[i] = (unsigned)((Ra_ - OV * (Ra_ >> 6)) * g.lda + C) * 2u; voffB[i] = (unsigned)(R * g.ldb + C) * 2u; } \
        aoff = lds_byte(wr * 64 + fr_, fq_ * 8); boff = lds_byte(wc * 32 + fr_, fq_ * 8); } while (0)
    PG8_LANE_STATE();
    const size_t kstep = (size_t)(BK * 2);
    const size_t hstepA = (size_t)(HALF - 2 * OV) * g.lda * 2, hstepB = (size_t)HALF * g.ldb * 2;
    const size_t tstepA = 2 * hstepA, tstepB = 2 * hstepB;
    const unsigned ldsw = (unsigned)wid * 1024u;
#define PG8_SA(b, h) (((b) * 2 + (h)) * HTB)
#define PG8_SB(b, h) ((4 + (b) * 2 + (h)) * HTB)
#define PG8_STAGE(bufoff, gbase, voff) do { _Pragma("unroll") for (int _i = 0; _i < 2; ++_i) \
        __builtin_amdgcn_global_load_lds((const unsigned*)((const char*)(gbase) + (voff)[_i]), (LAS unsigned*)(lds + (bufoff) + ldsw + _i * 8192), 16, 0, 0); } while (0)
#define PG8_LDA(dst, b, h) do { _Pragma("unroll") for (int m = 0; m < 4; ++m) _Pragma("unroll") for (int k = 0; k < 2; ++k) dst[m][k] = *(const LAS bf16x8*)(lds + PG8_SA(b, h) + aoff + m * 2048 + k * 1024); } while (0)
#define PG8_LDB(dst, b, h) do { _Pragma("unroll") for (int n = 0; n < 2; ++n) _Pragma("unroll") for (int k = 0; k < 2; ++k) dst[n][k] = *(const LAS bf16x8*)(lds + PG8_SB(b, h) + boff + n * 2048 + k * 1024); } while (0)
#define PG8_MMA(ai, bj, At, Bt) do { __builtin_amdgcn_s_setprio(1); _Pragma("unroll") for (int m = 0; m < 4; ++m) _Pragma("unroll") for (int n = 0; n < 2; ++n) _Pragma("unroll") for (int k = 0; k < 2; ++k) \
        acc[ai][bj][m][n] = __builtin_amdgcn_mfma_f32_16x16x32_bf16(Bt[n][k], At[m][k], acc[ai][bj][m][n], 0, 0, 0); __builtin_amdgcn_s_setprio(0); } while (0)
#define PG8_WAIT_V(n) asm volatile("s_waitcnt vmcnt(" #n ")" ::: "memory")
#define PG8_WAIT_L(n) asm volatile("s_waitcnt lgkmcnt(" #n ")" ::: "memory")
#define PG8_BAR __builtin_amdgcn_s_barrier()
#define PG8_SCHED __builtin_amdgcn_sched_barrier(0)
#define PG8_ABASE(u) ((const char*)g.A + ((long)Epi::rowtile((u).pm) * (BM - 4 * OV) - OV) * (long)g.lda * 2 + (long)(((u).pn / g.ks) * g.acoln + ((u).pn % g.ks) * g.kcol) * 2)
#define PG8_BBASE(u) ((const char*)g.Bt + (size_t)((u).pn / g.ks) * tstepB + (size_t)(((u).pn % g.ks) * g.kcol) * 2)
    Unit cur, nxt; int ui = 0;
    if (!S.next(0, cur)) return;
    E.prefetch(lds, wid, Epi::rowtile(cur.pm), cur.pn / g.ks, 0);
    f32x4 acc[2][2][4][2];
#pragma unroll
    for (int a = 0; a < 2; ++a)
#pragma unroll
        for (int b = 0; b < 2; ++b)
#pragma unroll
            for (int m = 0; m < 4; ++m)
#pragma unroll
                for (int n = 0; n < 2; ++n) acc[a][b][m][n] = (f32x4){0.f, 0.f, 0.f, 0.f};
    bf16x8 At[4][2], B0[2][2], B1[2][2];
    const char* cA = PG8_ABASE(cur); const char* cB = PG8_BBASE(cur);
    PG8_STAGE(PG8_SB(0, 0), cB, voffB); PG8_STAGE(PG8_SB(0, 1), cB + hstepB, voffB); PG8_STAGE(PG8_SA(0, 0), cA, voffA); PG8_STAGE(PG8_SA(0, 1), cA + hstepA, voffA);
    if (wr == 1) PG8_BAR;
    PG8_WAIT_V(2); PG8_BAR;
    PG8_STAGE(PG8_SB(1, 0), cB + kstep, voffB); PG8_STAGE(PG8_SA(1, 0), cA + kstep, voffA); PG8_STAGE(PG8_SB(1, 1), cB + hstepB + kstep, voffB);
    PG8_WAIT_V(6); PG8_BAR;
    for (;;) {
        const bool has_next = S.next(ui + 1, nxt);
        const char* nA = has_next ? PG8_ABASE(nxt) : cA; const char* nB = has_next ? PG8_BBASE(nxt) : cB;
        for (int t = 0; t < nt; t += 2) {
            const bool last = (t == nt - 2);
            const char* a1 = cA + (size_t)(t + 1) * kstep;
            const char* a2 = last ? nA : cA + (size_t)(t + 2) * kstep; const char* b2 = last ? nB : cB + (size_t)(t + 2) * kstep;
            const char* a3 = a2 + kstep; const char* b3 = b2 + kstep;
            PG8_LDB(B0, 0, 0); PG8_LDB(B1, 0, 1); PG8_SCHED; PG8_LDA(At, 0, 0); PG8_STAGE(PG8_SA(1, 1), a1 + hstepA, voffA);
            PG8_WAIT_V(8); PG8_WAIT_L(0); PG8_BAR; PG8_MMA(0, 0, At, B0); PG8_MMA(0, 1, At, B1); PG8_BAR; PG8_SCHED;
            PG8_LDA(At, 0, 1); PG8_STAGE(PG8_SB(0, 0), b2, voffB); PG8_STAGE(PG8_SB(0, 1), b2 + hstepB, voffB); PG8_STAGE(PG8_SA(0, 0), a2, voffA);
            PG8_WAIT_V(8); PG8_WAIT_L(0); PG8_BAR; PG8_MMA(1, 0, At, B0); PG8_MMA(1, 1, At, B1); PG8_BAR; PG8_SCHED;
            PG8_LDB(B0, 1, 0); PG8_LDB(B1, 1, 1); PG8_SCHED; PG8_LDA(At, 1, 0); PG8_STAGE(PG8_SA(0, 1), a2 + hstepA, voffA);
            PG8_WAIT_V(8); PG8_WAIT_L(0); PG8_BAR; PG8_MMA(0, 0, At, B0); PG8_MMA(0, 1, At, B1); PG8_BAR; PG8_SCHED;
            PG8_LDA(At, 1, 1); PG8_STAGE(PG8_SB(1, 0), b3, voffB); PG8_STAGE(PG8_SB(1, 1), b3 + hstepB, voffB); PG8_STAGE(PG8_SA(1, 0), a3, voffA);
            PG8_WAIT_V(8); PG8_WAIT_L(0); PG8_BAR; PG8_MMA(1, 0, At, B0); PG8_MMA(1, 1, At, B1); PG8_BAR; PG8_SCHED;
        }
        if (wr == 0) PG8_BAR;
        E(acc, Epi::rowtile(cur.pm), cur.pn / g.ks, wr, wc, 0, 0, lds, ui & 1);
        if (!has_next) break;
        PG8_LANE_STATE();
#pragma unroll
        for (int a = 0; a < 2; ++a)
#pragma unroll
            for (int b = 0; b < 2; ++b)
#pragma unroll
                for (int m = 0; m < 4; ++m)
#pragma unroll
                    for (int n = 0; n < 2; ++n) acc[a][b][m][n] = (f32x4){0.f, 0.f, 0.f, 0.f};
        cur = nxt; cA = nA; cB = nB; ++ui;
        E.prefetch(lds, wid, Epi::rowtile(cur.pm), cur.pn / g.ks, ui & 1);
        if (wr == 1) PG8_BAR;
    }
    PG8_WAIT_V(0);
    PG8_BAR;
#undef PG8_SA
#undef PG8_SB
#undef PG8_STAGE
#undef PG8_LDA
#undef PG8_LDB
#undef PG8_MMA
#undef PG8_WAIT_V
#undef PG8_WAIT_L
#undef PG8_BAR
#undef PG8_SCHED
#undef PG8_LANE_STATE
#undef PG8_ABASE
#undef PG8_BBASE
}
}

typedef f32x4 AccT[2][2][4][2];
#define EPI_FENCE() do { asm volatile("" ::: "memory"); __builtin_amdgcn_sched_barrier(0); } while (0)

struct EpiIn {
    bf16_t* cq; float* sscq; bf16_t* u; bf16_t* gates;
    const float* g_kv; const float* g_kr; const f32x2* tab; float* out; bf16_t* lat; bf16_t* krb;
    static DI int rowtile(int pm) { return pm; }
    DI void prefetch(LAS unsigned char*, int, int, int, int) const {}
    DI void operator()(const AccT& acc, int pm, int pn, int wr, int wc, int fr, int fq, LAS unsigned char* lds, int slot) const {
        { const int l_ = fresh_lane(); fr = l_ & 15; fq = l_ >> 4; }
        const int row0 = pm * 256 + wr * 64 + fr, cl = wc * 32 + 4 * fq;
        if (pn == 0) {
#pragma unroll
            for (int ai = 0; ai < 2; ++ai)
#pragma unroll
                for (int m = 0; m < 4; ++m) { const size_t row = (size_t)(row0 + ai * 128 + m * 16); float ss = 0.f;
#pragma unroll
                    for (int bj = 0; bj < 2; ++bj)
#pragma unroll
                        for (int n = 0; n < 2; ++n) { const int c = cl + 128 * bj + 16 * n; const f32x4 v = acc[ai][bj][m][n];
                            u32x2 w; w.x = cvtpk(v[0], v[1]); w.y = cvtpk(v[2], v[3]); *(u32x2*)(cq + row * QL + c) = w;
                            ss += (v[0] * v[0] + v[1] * v[1]) + (v[2] * v[2] + v[3] * v[3]); }
                    ss = rowsum4(ss);
                    if (fq == 0) (void)__hip_atomic_fetch_add(sscq + row, ss, __ATOMIC_RELAXED, __HIP_MEMORY_SCOPE_AGENT); }
        } else if (pn == 1) {
            LAS float* X = (LAS float*)(lds + 131072 + 1024);
#pragma unroll
            for (int ai = 0; ai < 2; ++ai)
#pragma unroll
                for (int m = 0; m < 4; ++m) { const f32x4 a = acc[ai][0][m][0], b = acc[ai][0][m][1];
                    float ss = (a[0] * a[0] + a[1] * a[1]) + (a[2] * a[2] + a[3] * a[3]) + (b[0] * b[0] + b[1] * b[1]) + (b[2] * b[2] + b[3] * b[3]);
                    ss = rowsum4(ss);
                    if (fq == 0) X[(ai * 128 + wr * 64 + m * 16 + fr) * 4 + wc] = ss; }
            asm volatile("s_waitcnt lgkmcnt(0)" ::: "memory"); __builtin_amdgcn_s_barrier(); asm volatile("" ::: "memory");
            f32x4 gkv[2];
#pragma unroll
            for (int n = 0; n < 2; ++n) gkv[n] = *(const f32x4*)(g_kv + cl + 16 * n);
#pragma unroll
            for (int ai = 0; ai < 2; ++ai)
#pragma unroll
                for (int m = 0; m < 4; ++m) { const int rt = ai * 128 + wr * 64 + m * 16 + fr, rowi = pm * 256 + rt; const size_t row = (size_t)rowi;
                    const f32x4 ps = *(const LAS f32x4*)(X + rt * 4);
                    const float rkv = rsqrtf(((ps[0] + ps[1]) + (ps[2] + ps[3])) * (1.0f / KVL) + EPS);
                    const size_t lrow = (size_t)lat_row(rowi);
                    float* ol = rowi < MP ? out + O_PLAT + row * KVL : out + O_SLAT + (size_t)(rowi - MP) * KVL;
#pragma unroll
                    for (int n = 0; n < 2; ++n) { const int c = cl + 16 * n; const f32x4 lt = acc[ai][0][m][n] * gkv[n] * rkv;
                        *(f32x4*)(ol + c) = lt; u32x2 w; w.x = cvtpk(lt[0], lt[1]); w.y = cvtpk(lt[2], lt[3]); *(u32x2*)(lat + lrow * KVL + c) = w; }
                    if (wc == 0) {
                        const f32x4 a = acc[ai][1][m][0], b = acc[ai][1][m][1];
                        float ss = (a[0] * a[0] + a[1] * a[1]) + (a[2] * a[2] + a[3] * a[3]) + (b[0] * b[0] + b[1] * b[1]) + (b[2] * b[2] + b[3] * b[3]);
                        ss = rowsum4(ss);
                        const float rk = rsqrtf(ss * (1.0f / ROPE) + EPS);
                        const f32x4 g1 = *(const f32x4*)(g_kr + 4 * fq), g2 = *(const f32x4*)(g_kr + 16 + 4 * fq);
                        const f32x2* tp = tab + (size_t)row_pos(rowi) * 16 + 4 * fq;
                        const f32x4 cs01 = *(const f32x4*)tp, cs23 = *(const f32x4*)(tp + 2);
                        const float cc[4] = {cs01[0], cs01[2], cs23[0], cs23[2]}, sn[4] = {cs01[1], cs01[3], cs23[1], cs23[3]};
                        f32x4 o1, o2;
#pragma unroll
                        for (int i = 0; i < 4; ++i) { const float x1 = a[i] * g1[i] * rk, x2 = b[i] * g2[i] * rk; o1[i] = x1 * cc[i] - x2 * sn[i]; o2[i] = x1 * sn[i] + x2 * cc[i]; }
                        float* ok = rowi < MP ? out + O_PKR + row * ROPE : out + O_SKR + (size_t)(rowi - MP) * ROPE;
                        *(f32x4*)(ok + 4 * fq) = o1; *(f32x4*)(ok + 16 + 4 * fq) = o2;
                        u32x2 w; w.x = cvtpk(o1[0], o1[1]); w.y = cvtpk(o1[2], o1[3]); *(u32x2*)(krb + lrow * ROPE + 4 * fq) = w;
                        w.x = cvtpk(o2[0], o2[1]); w.y = cvtpk(o2[2], o2[3]); *(u32x2*)(krb + lrow * ROPE + 16 + 4 * fq) = w; }
                    EPI_FENCE(); }
        } else {
#pragma unroll
            for (int ai = 0; ai < 2; ++ai)
#pragma unroll
                for (int m = 0; m < 4; ++m) { const size_t row = (size_t)(row0 + ai * 128 + m * 16);
#pragma unroll
                    for (int bj = 0; bj < 2; ++bj) { const int c = wc * 32 + 8 * fq + 128 * bj; const f32x4 v = acc[ai][bj][m][0], v2 = acc[ai][bj][m][1];
                            u32x4 w;
                            if (pn < 6) { w.x = cvtpk(v[0], v[1]); w.y = cvtpk(v[2], v[3]); w.z = cvtpk(v2[0], v2[1]); w.w = cvtpk(v2[2], v2[3]); *(u32x4*)(u + row * DM + (pn - 2) * 256 + c) = w; }
                            else { w.x = cvtpk(SG2(v[0]), SG2(v[1])); w.y = cvtpk(SG2(v[2]), SG2(v[3])); w.z = cvtpk(SG2(v2[0]), SG2(v2[1])); w.w = cvtpk(SG2(v2[2]), SG2(v2[3]));
                                *(u32x4*)(gates + row * 2048 + (pn - 6) * 256 + c) = w; } } }
        }
    }
};

struct EpiLru {
    const bf16_t* uc; const float* b_rg; const float* b_ig; const float* sp8; bf16_t* la; bf16_t* bt;
    static DI int rowtile(int pm) { return pm; }
    DI void prefetch(LAS unsigned char*, int, int, int, int) const {}
    DI void operator()(const AccT& acc, int pm, int pn, int wr, int wc, int fr, int fq, LAS unsigned char* lds, int slot) const {
        { const int l_ = fresh_lane(); fr = l_ & 15; fq = l_ >> 4; }
        const int row0 = pm * 256 + wr * 64 + fr, ch = pn * 128 + wc * 32 + 8 * fq;
        float nbr[8], nbi[8], spa[8], spb[8];
#pragma unroll
        for (int h = 0; h < 2; ++h) { const f32x4 brg = *(const f32x4*)(b_rg + ch + 4 * h), big = *(const f32x4*)(b_ig + ch + 4 * h), sp = *(const f32x4*)(sp8 + ch + 4 * h);
#pragma unroll
            for (int i = 0; i < 4; ++i) { nbr[4 * h + i] = -LOG2E * brg[i]; nbi[4 * h + i] = -LOG2E * big[i]; spa[4 * h + i] = sp[i] * LOG2E; spb[4 * h + i] = sp[i] * (2.0f * LOG2E); } }
#pragma unroll
        for (int ai = 0; ai < 2; ++ai) {
            u32x4 uw[4];
#pragma unroll
            for (int m = 0; m < 4; ++m) uw[m] = *(const u32x4*)(uc + (size_t)(row0 + ai * 128 + m * 16) * DM + ch);
#pragma unroll
            for (int m = 0; m < 4; ++m) { const size_t row = (size_t)(row0 + ai * 128 + m * 16);
                const float uv[8] = {bflo(uw[m].x), bfhi(uw[m].x), bflo(uw[m].y), bfhi(uw[m].y), bflo(uw[m].z), bfhi(uw[m].z), bflo(uw[m].w), bfhi(uw[m].w)};
                float lo[8], bo[8];
#pragma unroll
                for (int n = 0; n < 2; ++n)
#pragma unroll
                    for (int i = 0; i < 4; ++i) { const int k = 4 * n + i;
                        const float r = __builtin_amdgcn_rcpf(1.0f + __builtin_amdgcn_exp2f(acc[ai][0][m][n][i] * -LOG2E + nbr[k]));
                        const float ig = __builtin_amdgcn_rcpf(1.0f + __builtin_amdgcn_exp2f(acc[ai][1][m][n][i] * -LOG2E + nbi[k]));
                        const float m2 = 1.0f - __builtin_amdgcn_exp2f(r * spb[k]);
                        lo[k] = r * spa[k]; bo[k] = __builtin_amdgcn_sqrtf(m2) * ig * uv[k]; }
                u32x4 w; w.x = cvtpk(lo[0], lo[1]); w.y = cvtpk(lo[2], lo[3]); w.z = cvtpk(lo[4], lo[5]); w.w = cvtpk(lo[6], lo[7]); *(u32x4*)(la + row * DM + ch) = w;
                w.x = cvtpk(bo[0], bo[1]); w.y = cvtpk(bo[2], bo[3]); w.z = cvtpk(bo[4], bo[5]); w.w = cvtpk(bo[6], bo[7]); *(u32x4*)(bt + row * DM + ch) = w; }
            EPI_FENCE(); }
    }
};

struct EpiQ {
    unsigned char* wsq; const float* g_qn; const float* g_qr; const f32x2* tab; const float* sscq;
    static DI int rowtile(int pm) { return pm; }
    DI void prefetch(LAS unsigned char*, int, int, int, int) const {}
    DI void operator()(const AccT& acc, int pm, int pn, int wr, int wc, int fr, int fq, LAS unsigned char* lds, int slot) const {
        { const int l_ = fresh_lane(); fr = l_ & 15; fq = l_ >> 4; }
        const int row0 = pm * 256 + wr * 64 + fr;
        bf16_t* q = q_part(wsq, (size_t)pm * 256);
        float rqv[2][4];
#pragma unroll
        for (int ai = 0; ai < 2; ++ai)
#pragma unroll
            for (int m = 0; m < 4; ++m) rqv[ai][m] = rsqrtf(sscq[row0 + ai * 128 + m * 16] * (1.0f / QL) + EPS);
        if (pn < 4) {
            const int head = 4 * pn + wc;
            f32x4 gq[2][2];
#pragma unroll
            for (int bj = 0; bj < 2; ++bj)
#pragma unroll
                for (int n = 0; n < 2; ++n) gq[bj][n] = *(const f32x4*)(g_qn + 32 * bj + 8 * fq + 4 * n);
#pragma unroll
            for (int ai = 0; ai < 2; ++ai)
#pragma unroll
                for (int m = 0; m < 4; ++m) { const size_t row = (size_t)(row0 + ai * 128 + m * 16);
                    float ss = 0.f;
#pragma unroll
                    for (int bj = 0; bj < 2; ++bj)
#pragma unroll
                        for (int n = 0; n < 2; ++n) { const f32x4 v = acc[ai][bj][m][n]; ss += (v[0] * v[0] + v[1] * v[1]) + (v[2] * v[2] + v[3] * v[3]); }
                    ss = rowsum4(ss);
                    const float rq = rqv[ai][m], r = rsqrtf(rq * rq * ss * (1.0f / 64.0f) + EPS) * rq * QSCALE;
#pragma unroll
                    for (int bj = 0; bj < 2; ++bj) { const f32x4 v0 = acc[ai][bj][m][0] * gq[bj][0] * r, v1 = acc[ai][bj][m][1] * gq[bj][1] * r;
                        u32x4 w; w.x = cvtpk(v0[0], v0[1]); w.y = cvtpk(v0[2], v0[3]); w.z = cvtpk(v1[0], v1[1]); w.w = cvtpk(v1[2], v1[3]);
                        *(u32x4*)(q + row * 1536 + head * QKD + 32 * bj + 8 * fq) = w; }
                    EPI_FENCE(); }
        } else {
            const f32x4 g1 = *(const f32x4*)(g_qr + 4 * fq), g2 = *(const f32x4*)(g_qr + 16 + 4 * fq);
#pragma unroll
            for (int ai = 0; ai < 2; ++ai) {
                f32x4 t01[4], t23[4];
#pragma unroll
                for (int m = 0; m < 4; ++m) { const f32x2* tp = tab + (size_t)row_pos(row0 + ai * 128 + m * 16) * 16 + 4 * fq; t01[m] = *(const f32x4*)tp; t23[m] = *(const f32x4*)(tp + 2); }
#pragma unroll
                for (int m = 0; m < 4; ++m) { const int rowi = row0 + ai * 128 + m * 16; const size_t row = (size_t)rowi;
                    const f32x4 cs01 = t01[m], cs23 = t23[m];
                    const float cc[4] = {cs01[0], cs01[2], cs23[0], cs23[2]}, sn[4] = {cs01[1], cs01[3], cs23[1], cs23[3]};
#pragma unroll
                    for (int bj = 0; bj < 2; ++bj) { const int head = 8 * (pn - 4) + 4 * bj + wc;
                        const f32x4 a = acc[ai][bj][m][0], b = acc[ai][bj][m][1];
                        float ss = (a[0] * a[0] + a[1] * a[1]) + (a[2] * a[2] + a[3] * a[3]) + (b[0] * b[0] + b[1] * b[1]) + (b[2] * b[2] + b[3] * b[3]);
                        ss = rowsum4(ss);
                        const float rq = rqv[ai][m], r = rsqrtf(rq * rq * ss * (1.0f / 32.0f) + EPS) * rq * QSCALE;
                        float o1[4], o2[4];
#pragma unroll
                        for (int i = 0; i < 4; ++i) { const float x1 = a[i] * g1[i] * r, x2 = b[i] * g2[i] * r; o1[i] = x1 * cc[i] - x2 * sn[i]; o2[i] = x1 * sn[i] + x2 * cc[i]; }
                        u32x2 w; w.x = cvtpk(o1[0], o1[1]); w.y = cvtpk(o1[2], o1[3]); *(u32x2*)(q + row * 1536 + head * QKD + 64 + 4 * fq) = w;
                        w.x = cvtpk(o2[0], o2[1]); w.y = cvtpk(o2[2], o2[3]); *(u32x2*)(q + row * 1536 + head * QKD + 80 + 4 * fq) = w; }
                    EPI_FENCE(); }
            }
        }
    }
};

struct EpiKV {
    bf16_t* kn; bf16_t* v; const float* g_kn;
    static DI int rowtile(int pm) { return pm; }
    DI void prefetch(LAS unsigned char*, int, int, int, int) const {}
    DI void operator()(const AccT& acc, int pm, int pn, int wr, int wc, int fr, int fq, LAS unsigned char* lds, int slot) const {
        { const int l_ = fresh_lane(); fr = l_ & 15; fq = l_ >> 4; }
        const int row0 = pm * 256 + wr * 64 + fr;
        const int head = 4 * (pn & 3) + wc;
        f32x4 gk[2][2];
#pragma unroll
        for (int bj = 0; bj < 2; ++bj)
#pragma unroll
            for (int n = 0; n < 2; ++n) gk[bj][n] = *(const f32x4*)(g_kn + 32 * bj + 8 * fq + 4 * n);
#pragma unroll
        for (int ai = 0; ai < 2; ++ai)
#pragma unroll
            for (int m = 0; m < 4; ++m) { const size_t row = (size_t)(row0 + ai * 128 + m * 16);
                if (pn < 4) {
                    float ss = 0.f;
#pragma unroll
                    for (int bj = 0; bj < 2; ++bj)
#pragma unroll
                        for (int n = 0; n < 2; ++n) { const f32x4 x = acc[ai][bj][m][n]; ss += (x[0] * x[0] + x[1] * x[1]) + (x[2] * x[2] + x[3] * x[3]); }
                    ss = rowsum4(ss);
                    const float r = rsqrtf(ss * (1.0f / 64.0f) + EPS);
#pragma unroll
                    for (int bj = 0; bj < 2; ++bj) { const f32x4 v0 = acc[ai][bj][m][0] * gk[bj][0] * r, v1 = acc[ai][bj][m][1] * gk[bj][1] * r;
                        u32x4 w; w.x = cvtpk(v0[0], v0[1]); w.y = cvtpk(v0[2], v0[3]); w.z = cvtpk(v1[0], v1[1]); w.w = cvtpk(v1[2], v1[3]);
                        *(u32x4*)(kn + row * 1024 + head * 64 + 32 * bj + 8 * fq) = w; }
                } else {
#pragma unroll
                    for (int bj = 0; bj < 2; ++bj) { const f32x4 v0 = acc[ai][bj][m][0], v1 = acc[ai][bj][m][1];
                        u32x4 w; w.x = cvtpk(v0[0], v0[1]); w.y = cvtpk(v0[2], v0[3]); w.z = cvtpk(v1[0], v1[1]); w.w = cvtpk(v1[2], v1[3]);
                        *(u32x4*)(v + row * 1024 + head * 64 + 32 * bj + 8 * fq) = w; }
                }
                EPI_FENCE(); }
    }
};

struct EpiOut {
    const float* xp; bf16_t* xmb; float* ssrow;
    static DI int rowtile(int pm) { return pm; }
    DI void prefetch(LAS unsigned char*, int, int, int, int) const {}
    DI void operator()(const AccT& acc, int pm, int pn, int wr, int wc, int fr, int fq, LAS unsigned char* lds, int slot) const {
        { const int l_ = fresh_lane(); fr = l_ & 15; fq = l_ >> 4; }
        const int row0 = pm * 256 + wr * 64 + fr, cl = pn * 256 + wc * 32 + 8 * fq;
#pragma unroll
        for (int ai = 0; ai < 2; ++ai)
#pragma unroll
            for (int m = 0; m < 4; ++m) { const size_t row = (size_t)(row0 + ai * 128 + m * 16);
                const float* xr = xp + row * DM;
                float ss = 0.f;
#pragma unroll
                for (int bj = 0; bj < 2; ++bj) { const int c = cl + 128 * bj; const f32x4 v = *(const f32x4*)(xr + c) + acc[ai][bj][m][0], v2 = *(const f32x4*)(xr + c + 4) + acc[ai][bj][m][1];
                        u32x4 w; w.x = cvtpk(v[0], v[1]); w.y = cvtpk(v[2], v[3]); w.z = cvtpk(v2[0], v2[1]); w.w = cvtpk(v2[2], v2[3]); *(u32x4*)(xmb + (row + 2) * DM + c) = w;
                        ss += ((v[0] * v[0] + v[1] * v[1]) + (v[2] * v[2] + v[3] * v[3])) + ((v2[0] * v2[0] + v2[1] * v2[1]) + (v2[2] * v2[2] + v2[3] * v2[3])); }
                ss = rowsum4(ss);
                if (fq == 0) (void)__hip_atomic_fetch_add(ssrow + row + 2, ss, __ATOMIC_RELAXED, __HIP_MEMORY_SCOPE_AGENT); }
    }
};

constexpr int UP_SLOT0 = 131072 + 1024, UP_SLOT_BYTES = 5120;
template <bool FAST>
struct EpiUp {
    const float* ssrow; const float* cws; const float* st; bf16_t* hff; float* o_pffn; float* o_sffn;
    static constexpr int N_FAST = 62, N_SLOW = 7;
    static DI int rowtile(int pm) {
        if (FAST) { int r = pm + 1; if (r >= 16) ++r; if (r >= 33) ++r; if (r >= 49) ++r; return r; }
        return pm == 0 ? 0 : pm == 1 ? 16 : pm == 2 ? 33 : pm == 3 ? 49 : 62 + pm;
    }
    DI void prefetch(LAS unsigned char* lds, int wid, int pm, int pn, int slot) const {
        const int lane = fresh_lane();
        LAS unsigned char* sb = lds + UP_SLOT0 + slot * UP_SLOT_BYTES;
        const float* src = cws + (wid & 3) * NUP + (wid >> 2) * DFF + pn * 128 + lane;
        __builtin_amdgcn_global_load_lds((const unsigned*)src, (LAS unsigned*)(sb + wid * 512), 4, 0, 0);
        __builtin_amdgcn_global_load_lds((const unsigned*)(src + 64), (LAS unsigned*)(sb + wid * 512 + 256), 4, 0, 0);
        if (wid < 4) __builtin_amdgcn_global_load_lds((const unsigned*)(ssrow + (pm * 248 + 62 * wid + lane)), (LAS unsigned*)(sb + 4096 + wid * 256), 4, 0, 0);
    }
    DI void operator()(const AccT& acc, int pm, int pn, int wr, int wc, int fr, int fq, LAS unsigned char* lds, int slot) const {
        const LAS float* P = (const LAS float*)(lds + UP_SLOT0 + slot * UP_SLOT_BYTES);
        if constexpr (FAST) {
#pragma unroll
            for (int ai = 0; ai < 2; ++ai) {
                { const int l_ = fresh_lane(); fr = l_ & 15; fq = l_ >> 4; }
                const int seg = 2 * ai + wr, e0 = pm * 248 + 62 * seg - 2 + 4 * fr;
                const f32x4 ss4 = *(const LAS f32x4*)(P + 1024 + seg * 64 + 4 * fr);
                float r2[4];
#pragma unroll
                for (int m = 0; m < 4; ++m) r2[m] = rsqrtf(ss4[m] * (1.0f / DM) + EPS);
                u32x2 hpa[4];
#pragma unroll
                for (int n = 0; n < 2; ++n) { const int cc = wc * 32 + 8 * fq + 4 * n, ch = pn * 128 + cc;
                    f32x4 prm[8];
#pragma unroll
                    for (int k = 0; k < 8; ++k) prm[k] = *(const LAS f32x4*)(P + k * 128 + cc);
                    unsigned hp0[4];
#pragma unroll
                    for (int ip = 0; ip < 2; ++ip) {
                        float hres[4][2];
#pragma unroll
                        for (int ii = 0; ii < 2; ++ii) { const int i = 2 * ip + ii;
                            const float wg0 = prm[0][i], wg1 = prm[1][i], wg2 = prm[2][i], bg = prm[3][i], wv0 = prm[4][i], wv1 = prm[5][i], wv2 = prm[6][i], bv = prm[7][i];
                            float xg[4], xv[4];
#pragma unroll
                            for (int m = 0; m < 4; ++m) { xg[m] = acc[ai][0][m][n][i] * r2[m]; xv[m] = acc[ai][1][m][n][i] * r2[m]; }
                            float cg[4], cv[4];
                            cg[0] = wg2 * xg[0] + bg;                               cv[0] = wv2 * xv[0] + bv;
                            cg[1] = wg2 * xg[1] + (wg1 * xg[0] + bg);               cv[1] = wv2 * xv[1] + (wv1 * xv[0] + bv);
                            cg[2] = wg2 * xg[2] + (wg1 * xg[1] + (wg0 * xg[0] + bg)); cv[2] = wv2 * xv[2] + (wv1 * xv[1] + (wv0 * xv[0] + bv));
                            cg[3] = wg2 * xg[3] + (wg1 * xg[2] + (wg0 * xg[1] + bg)); cv[3] = wv2 * xv[3] + (wv1 * xv[2] + (wv0 * xv[1] + bv));
                            asm("s_nop 1\n\t"
                                "v_fmac_f32_dpp %0, %4, %6 row_ror:1 row_mask:0xf bank_mask:0xf\n\tv_fmac_f32_dpp %0, %5, %7 row_ror:1 row_mask:0xf bank_mask:0xf\n\tv_fmac_f32_dpp %1, %4, %7 row_ror:1 row_mask:0xf bank_mask:0xf\n\t"
                                "v_fmac_f32_dpp %2, %8, %10 row_ror:1 row_mask:0xf bank_mask:0xf\n\tv_fmac_f32_dpp %2, %9, %11 row_ror:1 row_mask:0xf bank_mask:0xf\n\tv_fmac_f32_dpp %3, %8, %11 row_ror:1 row_mask:0xf bank_mask:0xf"
                                : "+v"(cg[0]), "+v"(cg[1]), "+v"(cv[0]), "+v"(cv[1])
                                : "v"(xg[3]), "v"(xg[2]), "v"(wg1), "v"(wg0), "v"(xv[3]), "v"(xv[2]), "v"(wv1), "v"(wv0));
#pragma unroll
                            for (int m = 0; m < 4; ++m) hres[m][ii] = cg[m] * cv[m] * __builtin_amdgcn_rcpf(1.0f + __builtin_amdgcn_exp2f(cg[m]));
                        }
#pragma unroll
                        for (int m = 0; m < 4; ++m) { const unsigned pk = cvtpk(hres[m][0], hres[m][1]);
                            if (ip == 0) hp0[m] = pk;
                            else if (n == 0) { hpa[m].x = hp0[m]; hpa[m].y = pk; }
                            else if (m >= 2 || fr > 0) { u32x4 w; w.x = hpa[m].x; w.y = hpa[m].y; w.z = hp0[m]; w.w = pk; *(u32x4*)(hff + (size_t)(e0 + m) * DFF + ch - 4) = w; } }
                    }
                    EPI_FENCE();
                }
            }
            return;
        }
#pragma unroll
        for (int ai = 0; ai < 2; ++ai) {
            { const int l_ = fresh_lane(); fr = l_ & 15; fq = l_ >> 4; }
            const int e0 = pm * 248 + 62 * (2 * ai + wr) - 2 + fr;
            float r2[4];
#pragma unroll
            for (int m = 0; m < 4; ++m) r2[m] = rsqrtf(P[1024 + (2 * ai + wr) * 64 + 16 * m + fr] * (1.0f / DM) + EPS);
            unsigned long long bnd[4];
#pragma unroll
            for (int m = 0; m < 4; ++m) { const int j = 16 * m + fr, e = e0 + 16 * m; bool nd = false;
                if (j >= 2 && e < MT) { const int t = e < MP ? (e & (PT - 1)) : ((e - MP) & (ST - 1)); const int T = e < MP ? PT : ST; nd = (t < 2) || (t >= T - 2); }
                bnd[m] = __builtin_amdgcn_ballot_w64(nd); }
#pragma unroll
            for (int n = 0; n < 2; ++n) { const int cc = wc * 32 + 8 * fq + 4 * n, ch = pn * 128 + cc;
                f32x4 prm[8];
#pragma unroll
                for (int k = 0; k < 8; ++k) prm[k] = *(const LAS f32x4*)(P + k * 128 + cc);
                unsigned hp0[4];
#pragma unroll
                for (int ip = 0; ip < 2; ++ip) {
                    float hres[4][2];
#pragma unroll
                    for (int ii = 0; ii < 2; ++ii) { const int i = 2 * ip + ii;
                        const float wg0 = prm[0][i], wg1 = prm[1][i], wg2 = prm[2][i], bg = prm[3][i], wv0 = prm[4][i], wv1 = prm[5][i], wv2 = prm[6][i], bv = prm[7][i];
                        float pg = 0.f, pv = 0.f;
#pragma unroll
                        for (int m = 0; m < 4; ++m) {
                            const float xg = acc[ai][0][m][n][i] * r2[m], xv = acc[ai][1][m][n][i] * r2[m];
                            if (FAST) {
                                const float sg1 = fr == 15 ? pg : xg, sg2 = fr >= 14 ? pg : xg, sv1 = fr == 15 ? pv : xv, sv2 = fr >= 14 ? pv : xv;
                                float cg = wg2 * xg + bg, cv = wv2 * xv + bv;
                                asm("s_nop 1\n\tv_fmac_f32_dpp %0, %2, %4 row_ror:1 row_mask:0xf bank_mask:0xf\n\tv_fmac_f32_dpp %0, %3, %5 row_ror:2 row_mask:0xf bank_mask:0xf\n\t"
                                    "v_fmac_f32_dpp %1, %6, %8 row_ror:1 row_mask:0xf bank_mask:0xf\n\tv_fmac_f32_dpp %1, %7, %9 row_ror:2 row_mask:0xf bank_mask:0xf"
                                    : "+v"(cg), "+v"(cv) : "v"(sg1), "v"(sg2), "v"(wg1), "v"(wg0), "v"(sv1), "v"(sv2), "v"(wv1), "v"(wv0));
                                pg = xg; pv = xv;
                                hres[m][ii] = cg * cv * __builtin_amdgcn_rcpf(1.0f + __builtin_amdgcn_exp2f(cg));
                                continue;
                            }
                            float g1 = dpp_mov<0x121>(fr == 15 ? pg : xg), g2 = dpp_mov<0x122>(fr >= 14 ? pg : xg);
                            float v1 = dpp_mov<0x121>(fr == 15 ? pv : xv), v2 = dpp_mov<0x122>(fr >= 14 ? pv : xv);
                            pg = xg; pv = xv;
                            if (!FAST && bnd[m] != 0ull) {
                                const int j = 16 * m + fr, e = e0 + 16 * m;
                                if (j >= 2 && e < MT) {
                                    const int t = e < MP ? (e & (PT - 1)) : ((e - MP) & (ST - 1));
                                    const int T = e < MP ? PT : ST;
                                    if (t < 2) {
                                        float s0g = 0.f, s1g = 0.f, s0v = 0.f, s1v = 0.f;
                                        if (e >= MP) { const float* sb = st + (size_t)((e - MP) >> 5) * 2 * NUP + ch + i; s0g = sb[0]; s1g = sb[NUP]; s0v = sb[DFF]; s1v = sb[NUP + DFF]; }
                                        if (t == 0) { g1 = s1g; g2 = s0g; v1 = s1v; v2 = s0v; } else { g2 = s1g; v2 = s1v; }
                                    }
                                    if (t >= T - 2) {
                                        float* ob = (e < MP ? o_pffn + ((size_t)(e >> 12) * 2 + (t - (T - 2))) * NUP : o_sffn + ((size_t)((e - MP) >> 5) * 2 + (t - (T - 2))) * NUP) + ch + i;
                                        ob[0] = xg; ob[DFF] = xv; }
                                }
                            }
                            const float cg = wg0 * g2 + wg1 * g1 + wg2 * xg + bg, cv = wv0 * v2 + wv1 * v1 + wv2 * xv + bv;
                            hres[m][ii] = cg * cv * __builtin_amdgcn_rcpf(1.0f + __builtin_amdgcn_exp2f(cg));
                        }
                    }
#pragma unroll
                    for (int m = 0; m < 4; ++m) { const int j = 16 * m + fr, e = e0 + 16 * m; const unsigned pk = cvtpk(hres[m][0], hres[m][1]);
                        if (ip == 0) hp0[m] = pk; else if (j >= 2 && (FAST || e < MT)) { u32x2 w; w.x = hp0[m]; w.y = pk; *(u32x2*)(hff + (size_t)e * DFF + ch) = w; } }
                    if (!FAST) EPI_FENCE();
                }
                EPI_FENCE();
            }
        }
    }
};
namespace pg8 { template <> struct RowPerm<EpiUp<true>> { static constexpr bool v = true; }; }

struct EpiDown {
    const bf16_t* xmb; float* y;
    static DI int rowtile(int pm) { return pm; }
    DI void prefetch(LAS unsigned char*, int, int, int, int) const {}
    DI void operator()(const AccT& acc, int pm, int pn, int wr, int wc, int fr, int fq, LAS unsigned char* lds, int slot) const {
        { const int l_ = fresh_lane(); fr = l_ & 15; fq = l_ >> 4; }
        const int row0 = pm * 256 + wr * 64 + fr, cl = pn * 256 + wc * 32 + 4 * fq;
#pragma unroll
        for (int ai = 0; ai < 2; ++ai)
#pragma unroll
            for (int m = 0; m < 4; ++m) { const size_t row = (size_t)(row0 + ai * 128 + m * 16); float* yr = y + row * DM; const bf16_t* xr = xmb + (row + 2) * DM;
#pragma unroll
                for (int bj = 0; bj < 2; ++bj)
#pragma unroll
                    for (int n = 0; n < 2; ++n) { const int c = cl + 128 * bj + 16 * n; const u32x2 w = *(const u32x2*)(xr + c);
                        *(f32x4*)(yr + c) = (f32x4){bflo(w.x), bfhi(w.x), bflo(w.y), bfhi(w.y)} + acc[ai][bj][m][n]; } }
    }
};

constexpr int NWAVES = 8, NTHREADS = 512;
constexpr int RING_BYTES = 131072, LDS_BYTES = 147456;
constexpr int N_PHASES = 8;

struct Args { const float* in[30]; float* out; unsigned char* ws; int ph_lo, ph_hi; };

struct Frame {
    LAS unsigned char* lds; int wave, G, bid; unsigned char* ws; float* out;
    DI const float* in(int i) const { const LAS unsigned* p = (const LAS unsigned*)(lds + RING_BYTES) + 2 * i; const unsigned lo_ = __builtin_amdgcn_readfirstlane(p[0]), hi_ = __builtin_amdgcn_readfirstlane(p[1]);
        return (const float*)(((unsigned long long)hi_ << 32) | lo_); }
};

DI void tr_item(const float* W, int ldw, const float* fold, bf16_t* WT, int K, int k0, int nrow0, int sc, LAS float* scr, int lane, float cs = 1.0f) {
    f32x4 v[8];
#pragma unroll
    for (int i = 0; i < 8; ++i) { const int kk = (lane >> 3) + 8 * i; v[i] = (f32x4){0.f, 0.f, 0.f, 0.f};
        if (sc >= 0) { v[i] = *(const f32x4*)(W + (size_t)(k0 + kk) * ldw + sc) * cs; if (fold) v[i] = v[i] * fold[k0 + kk]; } }
#pragma unroll
    for (int i = 0; i < 8; ++i) { const int kk = (lane >> 3) + 8 * i; LAS float* d = scr + kk * 33 + 4 * (lane & 7); d[0] = v[i][0]; d[1] = v[i][1]; d[2] = v[i][2]; d[3] = v[i][3]; }
    LDS_WAIT();
    const int c = lane & 7;
#pragma unroll
    for (int j = 0; j < 4; ++j) { const int n = (lane >> 3) + 8 * j; const LAS float* s = scr + (8 * c) * 33 + n;
        u32x4 o; o.x = cvtpk(s[0 * 33], s[1 * 33]); o.y = cvtpk(s[2 * 33], s[3 * 33]); o.z = cvtpk(s[4 * 33], s[5 * 33]); o.w = cvtpk(s[6 * 33], s[7 * 33]);
        *(u32x4*)(WT + (size_t)(nrow0 + n) * K + k0 + 8 * c) = o; }
    LDS_WAIT();
}
DI int dperm(int cc, int bj) { return 32 * bj + 8 * ((cc >> 2) & 3) + 4 * ((cc >> 4) & 1) + (cc & 3); }
DI int src_win(int n) { if (n < 416) return n; if (n < 512) return -1; const int s_ = n - 512; return 416 + (s_ & ~31) + dperm(s_ & 31, 0); }
DI int src_wqb(int n) { const int pn = n >> 8, c = n & 255, bj = c >> 7, wc = (c >> 5) & 3, cc = c & 31;
    if (pn < 4) return (4 * pn + wc) * QKD + dperm(cc, bj);
    return (8 * (pn - 4) + 4 * bj + wc) * QKD + 64 + cc; }
DI int src_wkvb(int n) { const int pn = n >> 8, c = n & 255, bj = c >> 7, wc = (c >> 5) & 3, cc = c & 31;
    if (pn < 4) return (4 * pn + wc) * 128 + dperm(cc, bj);
    return (4 * (pn - 4) + wc) * 128 + 64 + dperm(cc, bj); }
DI int src_wup(int n) { const int pn = n >> 8, c = n & 255; return (c >> 7) * DFF + 128 * pn + (c & 96) + dperm(c & 31, 0); }

struct TrDesc { const float* W; const float* fold; bf16_t* WT; int ldw, K, k0, nrow0, sc; };
DI TrDesc late_desc(Frame& F, int r, int lane) {
    constexpr int I_OUT = 16 * 32, I_UP = 16 * 176;
    unsigned char* ws = F.ws;
    if (r < I_OUT) { const int kb = r / 32, nb = r % 32; return TrDesc{F.in(24), nullptr, (bf16_t*)(ws + WS_WOUT), 1024, 1024, 64 * kb, 32 * nb, 32 * nb + dperm(4 * (lane & 7), 0)}; }
    r -= I_OUT;
    if (r < I_UP) { const int kb = r / 176, nb = r % 176; return TrDesc{F.in(26), F.in(25), (bf16_t*)(ws + WS_WUP), NUP, 1024, 64 * kb, 32 * nb, src_wup(32 * nb + 4 * (lane & 7))}; }
    r -= I_UP;
    { const int kb = r / 32, nb = r % 32; return TrDesc{F.in(29), nullptr, (bf16_t*)(ws + WS_WDOWN), 1024, DFF, 64 * kb, 32 * nb, 32 * nb + 4 * (lane & 7)}; }
}
DI void tr_issue(const TrDesc& d, f32x4 (&v)[8], float (&fv)[8], int lane) {
#pragma unroll
    for (int i = 0; i < 8; ++i) { const int kk = (lane >> 3) + 8 * i; v[i] = *(const f32x4*)(d.W + (size_t)(d.k0 + kk) * d.ldw + d.sc); fv[i] = d.fold ? d.fold[d.k0 + kk] : 1.0f; }
}
DI void tr_finish(const TrDesc& d, const f32x4 (&v)[8], const float (&fv)[8], LAS float* scr, int lane) {
#pragma unroll
    for (int i = 0; i < 8; ++i) { const int kk = (lane >> 3) + 8 * i; LAS float* dd = scr + kk * 33 + 4 * (lane & 7); const f32x4 x = v[i] * fv[i]; dd[0] = x[0]; dd[1] = x[1]; dd[2] = x[2]; dd[3] = x[3]; }
    LDS_WAIT();
    const int c = lane & 7;
#pragma unroll
    for (int j = 0; j < 4; ++j) { const int n = (lane >> 3) + 8 * j; const LAS float* sp = scr + (8 * c) * 33 + n;
        u32x4 o; o.x = cvtpk(sp[0 * 33], sp[1 * 33]); o.y = cvtpk(sp[2 * 33], sp[3 * 33]); o.z = cvtpk(sp[4 * 33], sp[5 * 33]); o.w = cvtpk(sp[6 * 33], sp[7 * 33]);
        *(u32x4*)(d.WT + (size_t)(d.nrow0 + n) * d.K + d.k0 + 8 * c) = o; }
    LDS_WAIT();
}
constexpr int LATE_ITEMS = 16 * 32 + 16 * 176 + 44 * 32, LATE_DOWN0 = 16 * 32 + 16 * 176;
DI void late_weights(Frame& F, int worker, int nworkers, int it_lo, int NIT) {
    LAS float* scr = (LAS float*)(F.lds + F.wave * 16384);
    const int lane = fresh_lane();
    int r0 = it_lo + worker; if (r0 >= NIT) return;
    TrDesc dc = late_desc(F, r0, lane); f32x4 vc[8]; float fc[8];
    tr_issue(dc, vc, fc, lane);
    for (;;) {
        const int rn = r0 + nworkers; const bool more = rn < NIT;
        TrDesc dn = dc; f32x4 vn[8]; float fn[8];
        if (more) { dn = late_desc(F, rn, lane); tr_issue(dn, vn, fn, lane); }
        tr_finish(dc, vc, fc, scr, lane);
        if (!more) break;
        dc = dn; r0 = rn;
#pragma unroll
        for (int i = 0; i < 8; ++i) { vc[i] = vn[i]; fc[i] = fn[i]; }
    }
}

constexpr int CACHE_P0 = 2;
constexpr int CACHE_LATE = 8;
DI void cache_convert(Frame& F, int gt, int NGT, int s_lo, int s_hi) {
    unsigned char* ws = F.ws;
    { const float* cl = F.in(2); const float* ck = F.in(3);
      const int l_lo = s_lo * PAST * (KVL / 8), l_hi = s_hi * PAST * (KVL / 8);
      for (int i0 = l_lo + gt; i0 < l_hi; i0 += 4 * NGT) {
        f32x4 a[4], bq[4];
#pragma unroll
        for (int q = 0; q < 4; ++q) { int i = i0 + q * NGT; i = i < l_hi ? i : l_hi - 1; const float* sp = cl + (size_t)(i >> 4) * KVL + (i & 15) * 8; a[q] = *(const f32x4*)sp; bq[q] = *(const f32x4*)(sp + 4); }
#pragma unroll
        for (int q = 0; q < 4; ++q) { const int i = i0 + q * NGT; if (i >= l_hi) break; const int row = i >> 4, c8 = (i & 15) * 8, b = row >> 12, j = row & 4095;
            u32x4 w; w.x = cvtpk(a[q][0], a[q][1]); w.y = cvtpk(a[q][2], a[q][3]); w.z = cvtpk(bq[q][0], bq[q][1]); w.w = cvtpk(bq[q][2], bq[q][3]);
            *(u32x4*)((bf16_t*)(ws + WS_LAT) + (size_t)(MP + b * SKEYS + j) * KVL + c8) = w; } }
      const int r_lo = s_lo * PAST * (ROPE / 8), r_hi = s_hi * PAST * (ROPE / 8);
      for (int i = r_lo + gt; i < r_hi; i += NGT) { const int row = i >> 2, c8 = (i & 3) * 8, b = row >> 12, j = row & 4095;
        const float* sp = ck + (size_t)row * ROPE + c8; const f32x4 a = *(const f32x4*)sp, bq = *(const f32x4*)(sp + 4);
        u32x4 w; w.x = cvtpk(a[0], a[1]); w.y = cvtpk(a[2], a[3]); w.z = cvtpk(bq[0], bq[1]); w.w = cvtpk(bq[2], bq[3]);
        *(u32x4*)((bf16_t*)(ws + WS_KR) + (size_t)(MP + b * SKEYS + j) * ROPE + c8) = w; } }
}

DI void p0_prologue(Frame& F) {
    LAS float* scr = (LAS float*)(F.lds + F.wave * 16384);
    const int lane = fresh_lane(), tid = F.wave * 64 + lane;
    const int gw = F.bid * NWAVES + F.wave, NGW = F.G * NWAVES;
    unsigned char* ws = F.ws;
    constexpr int I_IN = 16 * 112, I_QB = 4 * 48, I_KVB = 2 * 64, I_KVN = 2 * 64, I_LRU = 16 * 8;
    constexpr int NITEMS = I_IN + I_QB + I_KVB + I_KVN + I_LRU;
    for (int it = gw; it < NITEMS; it += NGW) {
        int r = it;
        if (r < I_IN) { const int kb = r / 112, nb = r % 112; tr_item(F.in(8), 3488, nullptr, (bf16_t*)(ws + WS_WIN), 1024, 64 * kb, 32 * nb, src_win(32 * nb + 4 * (lane & 7)), scr, lane, nb >= 48 ? -LOG2E : 1.0f); continue; } r -= I_IN;
        if (r < I_QB) { const int kb = r / 48, nb = r % 48; tr_item(F.in(10), 1536, F.in(9), (bf16_t*)(ws + WS_WQB), 256, 64 * kb, 32 * nb, src_wqb(32 * nb + 4 * (lane & 7)), scr, lane); continue; } r -= I_QB;
        if (r < I_KVB) { const int kb = r / 64, nb = r % 64; tr_item(F.in(12), 2048, nullptr, (bf16_t*)(ws + WS_WKVB), 128, 64 * kb, 32 * nb, src_wkvb(32 * nb + 4 * (lane & 7)), scr, lane); continue; } r -= I_KVB;
        if (r < I_KVN) { const int kb = r / 64, nb = r % 64; tr_item(F.in(12), 2048, nullptr, (bf16_t*)(ws + WS_WKVN), 128, 64 * kb, 32 * nb, 32 * nb + 4 * (lane & 7), scr, lane); continue; } r -= I_KVN;
        { const int mat = r >> 3, sub = r & 7, blk = mat >> 1, bj = mat & 1, kb = sub >> 2, nb = sub & 3;
            tr_item((bj ? F.in(21) : F.in(19)) + (size_t)blk * 16384, 128, nullptr, (bf16_t*)(ws + WS_WLRU), 128, 64 * kb, blk * 256 + bj * 128 + 32 * nb, 32 * nb + dperm(4 * (lane & 7), 0), scr, lane); }
    }
    const float* gm = F.in(7);
    { const float* x0 = F.in(0); const float* x1 = F.in(1);
      for (int m0 = 2 * gw; m0 < MT; m0 += 2 * NGW) {
        f32x4 v[2][4]; float s[2];
#pragma unroll
        for (int q = 0; q < 2; ++q) { const int m = m0 + q; const float* xr = m < MP ? x0 + (size_t)m * DM : x1 + (size_t)(m - MP) * DM; s[q] = 0.f;
#pragma unroll
            for (int j = 0; j < 4; ++j) { v[q][j] = *(const f32x4*)(xr + 4 * lane + 256 * j); s[q] += (v[q][j][0] * v[q][j][0] + v[q][j][1] * v[q][j][1]) + (v[q][j][2] * v[q][j][2] + v[q][j][3] * v[q][j][3]); } }
#pragma unroll
        for (int q = 0; q < 2; ++q) { const float r = rsqrtf(wave_sum(s[q]) * (1.0f / DM) + EPS);
            bf16_t* o = (bf16_t*)(ws + WS_XN) + (size_t)(m0 + q) * DM;
#pragma unroll
            for (int j = 0; j < 4; ++j) { const f32x4 g = *(const f32x4*)(gm + 4 * lane + 256 * j); const f32x4 y = v[q][j] * g * r;
                u32x2 w; w.x = cvtpk(y[0], y[1]); w.y = cvtpk(y[2], y[3]); *(u32x2*)(o + 4 * lane + 256 * j) = w; } }
      } }
    const int gt = F.bid * NTHREADS + tid, NGT = F.G * NTHREADS;
    cache_convert(F, gt, NGT, 0, F.G == 256 ? CACHE_P0 : SB);
    for (int i = gt; i < MT; i += NGT) ((float*)(ws + WS_SSCQ))[i] = 0.f;
    for (int i = gt; i < XMB_ROWS + 2; i += NGT) ((float*)(ws + WS_SSROW))[i] = 0.f;
    for (int i = gt; i < 4 * NUP; i += NGT) { const int row = i / NUP, c = i - row * NUP;
        ((float*)(ws + WS_CWS))[i] = (row < 3 ? F.in(27)[i] : F.in(28)[c]) * (c < DFF ? -1.4426950408889634f : -0.6931471805599453f); }
    for (int i = gt; i < DM; i += NGT) { const float x = -F.in(23)[i]; ((float*)(ws + WS_SP8))[i] = -8.0f * (x > 15.f ? x : log1pf(__expf(x))); }
    for (int i = gt; i < SKEYS * 16; i += NGT) { const int pos = i >> 4, k = i & 15;
        const float inv = exp2f(-(float)k * (13.287712379549449f / 16.0f));
        const double rev = (double)((float)pos * inv) * 0.15915494309189535;
        const float fr_ = (float)(rev - floor(rev));
        ((f32x2*)(ws + WS_TAB))[i] = (f32x2){__builtin_amdgcn_cosf(fr_), __builtin_amdgcn_sinf(fr_)}; }
}

template <int GR>
DI void conv_rows(Frame& F, const int m0, const int c, const bf16_t* u, const float* cw, const float* cb, const float* cst) {
    const int t0 = m0 < MP ? (m0 & (PT - 1)) : ((m0 - MP) & (ST - 1)); const int T = m0 < MP ? PT : ST;
    u32x4 ux[GR + 3];
#pragma unroll
    for (int i = 0; i < GR + 3; ++i) { const int row = (t0 == 0 && i < 3) ? m0 : m0 - 3 + i;
        ux[i] = *(const u32x4*)(u + (size_t)row * DM + c); }
    float x[GR + 3][8];
#pragma unroll
    for (int i = 0; i < GR + 3; ++i) { const u32x4 w = ux[i];
        x[i][0] = bflo(w.x); x[i][1] = bfhi(w.x); x[i][2] = bflo(w.y); x[i][3] = bfhi(w.y); x[i][4] = bflo(w.z); x[i][5] = bfhi(w.z); x[i][6] = bflo(w.w); x[i][7] = bfhi(w.w); }
    if (t0 == 0) {
#pragma unroll
        for (int i = 0; i < 3; ++i) {
            if (m0 >= MP) { const float* sp = cst + ((size_t)((m0 - MP) >> 5) * 3 + i) * DM + c; const f32x4 a = *(const f32x4*)sp, b = *(const f32x4*)(sp + 4);
                x[i][0] = a[0]; x[i][1] = a[1]; x[i][2] = a[2]; x[i][3] = a[3]; x[i][4] = b[0]; x[i][5] = b[1]; x[i][6] = b[2]; x[i][7] = b[3]; }
            else {
#pragma unroll
                for (int e = 0; e < 8; ++e) x[i][e] = 0.f; } } }
    f32x4 w0[4], w1[4];
#pragma unroll
    for (int j = 0; j < 4; ++j) { w0[j] = *(const f32x4*)(cw + j * DM + c); w1[j] = *(const f32x4*)(cw + j * DM + c + 4); }
    const f32x4 b0 = *(const f32x4*)(cb + c), b1 = *(const f32x4*)(cb + c + 4);
    bf16_t* ucp = (bf16_t*)(F.ws + WS_UC);
#pragma unroll
    for (int r = 0; r < GR; ++r) { const int m = m0 + r, t = t0 + r;
        float y[8];
#pragma unroll
        for (int e = 0; e < 4; ++e) { y[e] = b0[e]; y[4 + e] = b1[e]; }
#pragma unroll
        for (int j = 0; j < 4; ++j)
#pragma unroll
            for (int e = 0; e < 4; ++e) { y[e] += w0[j][e] * x[r + j][e]; y[4 + e] += w1[j][e] * x[r + j][4 + e]; }
        u32x4 w; w.x = cvtpk(y[0], y[1]); w.y = cvtpk(y[2], y[3]); w.z = cvtpk(y[4], y[5]); w.w = cvtpk(y[6], y[7]);
        *(u32x4*)(ucp + (size_t)m * DM + c) = w;
        if (t >= T - 3) { float* oc = m < MP ? F.out + O_PCONV + ((size_t)(m >> 12) * 3 + (t - (T - 3))) * DM : F.out + O_SCONV + ((size_t)((m - MP) >> 5) * 3 + (t - (T - 3))) * DM;
            *(f32x4*)(oc + c) = (f32x4){x[r + 3][0], x[r + 3][1], x[r + 3][2], x[r + 3][3]}; *(f32x4*)(oc + c + 4) = (f32x4){x[r + 3][4], x[r + 3][5], x[r + 3][6], x[r + 3][7]}; } }
}
DI void conv_own_units(Frame& F, const pg8::StaticOrder& S) {
    const int tid = F.wave * 64 + fresh_lane();
    const bf16_t* u = (const bf16_t*)(F.out + O_Y); const float* cw = F.in(17); const float* cb = F.in(18); const float* cst = F.in(5);
    pg8::Unit un;
    for (int i = 0; S.next(i, un); ++i) conv_rows<8>(F, un.pm * 256 + (tid >> 4) * 8, un.pn * 128 + (tid & 15) * 8, u, cw, cb, cst);
    asm volatile("s_waitcnt vmcnt(0)" ::: "memory"); __syncthreads();
}

DI void lru_small(Frame& F) {
    const int lane = fresh_lane(), wid = F.wave, l15 = lane & 15, kq = lane >> 4;
    const bf16_t* uc = (const bf16_t*)(F.ws + WS_UC); const bf16_t* wl = (const bf16_t*)(F.ws + WS_WLRU);
    bf16_t* la = (bf16_t*)(F.ws + WS_LA); bf16_t* bt = (bf16_t*)(F.ws + WS_BT);
    const float* b_rg = F.in(20); const float* b_ig = F.in(22); const float* sp8 = (const float*)(F.ws + WS_SP8);
    for (int task = F.bid; task < (MS / 16) * 8; task += F.G) {
        const int rbk = task >> 3, blk = task & 7;
        if (wid == 0) conv_rows<4>(F, MP + rbk * 16 + (lane >> 4) * 4, blk * 128 + (lane & 15) * 8, (const bf16_t*)(F.out + O_Y), F.in(17), F.in(18), F.in(5));
        asm volatile("s_waitcnt vmcnt(0)" ::: "memory"); __syncthreads();
        const bf16_t* ap = uc + (size_t)(MP + rbk * 16 + l15) * DM + blk * 128 + 8 * kq;
        const bf16_t* bp = wl + (size_t)(blk * 256 + 16 * wid + l15) * 128 + 8 * kq;
        bf16x8 a[4], br[4], bi[4];
#pragma unroll
        for (int s = 0; s < 4; ++s) { a[s] = *(const bf16x8*)(ap + 32 * s); br[s] = *(const bf16x8*)(bp + 32 * s); bi[s] = *(const bf16x8*)(bp + (size_t)128 * 128 + 32 * s); }
        f32x4 cr = (f32x4){0.f, 0.f, 0.f, 0.f}, ci = cr;
#pragma unroll
        for (int s = 0; s < 4; ++s) { cr = __builtin_amdgcn_mfma_f32_16x16x32_bf16(a[s], br[s], cr, 0, 0, 0); ci = __builtin_amdgcn_mfma_f32_16x16x32_bf16(a[s], bi[s], ci, 0, 0, 0); }
        const int ch = blk * 128 + ((16 * wid + l15) & ~31) + dperm((16 * wid + l15) & 31, 0);
        const float brg = b_rg[ch], big = b_ig[ch], sp = sp8[ch];
#pragma unroll
        for (int r = 0; r < 4; ++r) { const size_t row = (size_t)MP + rbk * 16 + 4 * kq + r;
            const float uv = bf2f(uc[row * DM + ch]);
            const float rg = sigmoidf_(cr[r] + brg), ig = sigmoidf_(ci[r] + big);
            const float loga = rg * sp, m2 = 1.0f - __builtin_amdgcn_exp2f(2.0f * loga * LOG2E);
            la[row * DM + ch] = (bf16_t)(cvtpk(loga * LOG2E, 0.f) & 0xffffu);
            bt[row * DM + ch] = (bf16_t)(cvtpk(sqrtf(m2) * ig * uv, 0.f) & 0xffffu); }
    }
}

DI void scan_local_own(Frame& F, const pg8::StaticOrder& S) {
    const bf16_t* la = (const bf16_t*)(F.ws + WS_LA); const bf16_t* bt = (const bf16_t*)(F.ws + WS_BT);
    float* Ap = (float*)(F.ws + WS_AGG); float* Bp = Ap + PB * 64 * DM;
    const int tid = F.wave * 64 + fresh_lane();
    asm volatile("s_waitcnt vmcnt(0)" ::: "memory"); __syncthreads();
    pg8::Unit u;
    for (int i = 0; S.next(i, u); i += 2) {
        pg8::Unit v = u; const int which = tid >> 8; bool have = true;
        if (which == 1) have = S.next(i + 1, v);
        if (have) { const int seg4 = (tid >> 6) & 3, cp = v.pn * 64 + (tid & 63);
            const int row0 = v.pm * 256 + seg4 * 64, b = row0 >> 12, seg = (row0 & (PT - 1)) >> 6; const size_t base = (size_t)row0 * DM + 2 * cp;
            float A0 = 1.f, A1 = 1.f, H0 = 0.f, H1 = 0.f;
#pragma unroll 8
            for (int t = 0; t < 64; ++t) { const unsigned lw = *(const unsigned*)(la + base + (size_t)t * DM), bw = *(const unsigned*)(bt + base + (size_t)t * DM);
                const float a0 = __builtin_amdgcn_exp2f(bflo(lw)), a1 = __builtin_amdgcn_exp2f(bfhi(lw)); H0 = a0 * H0 + bflo(bw); H1 = a1 * H1 + bfhi(bw); A0 *= a0; A1 *= a1; }
            *(f32x2*)(Ap + ((size_t)b * 64 + seg) * DM + 2 * cp) = (f32x2){A0, A1}; *(f32x2*)(Bp + ((size_t)b * 64 + seg) * DM + 2 * cp) = (f32x2){H0, H1}; }
    }
}
constexpr int SCAN_EXTRA0 = (MT / 256) * 6 - 256;
DI void p5_scan_apply(Frame& F) {
    const bf16_t* la = (const bf16_t*)(F.ws + WS_LA); const bf16_t* bt = (const bf16_t*)(F.ws + WS_BT); bf16_t* gates = (bf16_t*)(F.ws + WS_GATES);
    const float* Ap = (const float*)(F.ws + WS_AGG); const float* Bp = Ap + PB * 64 * DM;
    const int NP = PB * 64 * 512, NS = SB * 512;
    const int tid = F.wave * 64 + fresh_lane();
    for (int it = 0;; ++it) {
        int idx;
        if (F.G == 256) { if (it == 0) idx = (F.bid >> 6) * 32768 + (((F.bid & 63) + 8 * F.wave) & 63) * 512 + tid;
            else if (it == 1 && F.bid >= SCAN_EXTRA0 && F.bid < SCAN_EXTRA0 + NS / NTHREADS) idx = NP + (F.bid - SCAN_EXTRA0) * NTHREADS + tid; else break; }
        else { idx = F.bid * NTHREADS + tid + it * F.G * NTHREADS; if (idx >= NP + NS) break; }
        float H0, H1; size_t row0; int nsteps; float* oh = nullptr; int cp;
        if (idx < NP) { cp = idx & 511; const int seg = (idx >> 9) & 63, b = idx >> 15; H0 = 0.f; H1 = 0.f;
            for (int s0 = 0; s0 < seg; s0 += 8) {
                f32x2 a[8], h[8];
#pragma unroll
                for (int q = 0; q < 8; ++q) { const int si = s0 + q < 63 ? s0 + q : 63; a[q] = *(const f32x2*)(Ap + ((size_t)b * 64 + si) * DM + 2 * cp); h[q] = *(const f32x2*)(Bp + ((size_t)b * 64 + si) * DM + 2 * cp); }
#pragma unroll
                for (int q = 0; q < 8; ++q) if (s0 + q < seg) { H0 = a[q][0] * H0 + h[q][0]; H1 = a[q][1] * H1 + h[q][1]; } }
            row0 = (size_t)b * PT + seg * 64; nsteps = 64; if (seg == 63) oh = F.out + O_PH + (size_t)b * DM + 2 * cp; }
        else { const int j = idx - NP; cp = j & 511; const int b = j >> 9; const f32x2 h = *(const f32x2*)(F.in(4) + (size_t)b * DM + 2 * cp); H0 = h[0]; H1 = h[1];
            row0 = (size_t)MP + b * ST; nsteps = ST; oh = F.out + O_SH + (size_t)b * DM + 2 * cp; }
        for (int t0 = 0; t0 < nsteps; t0 += 8) {
            unsigned lw[8], bw[8], gv[8];
#pragma unroll
            for (int t = 0; t < 8; ++t) { const size_t r = row0 + t0 + t; lw[t] = *(const unsigned*)(la + r * DM + 2 * cp); bw[t] = *(const unsigned*)(bt + r * DM + 2 * cp); gv[t] = *(const unsigned*)(gates + r * 2048 + 1024 + 2 * cp); }
#pragma unroll
            for (int t = 0; t < 8; ++t) { H0 = __builtin_amdgcn_exp2f(bflo(lw[t])) * H0 + bflo(bw[t]); H1 = __builtin_amdgcn_exp2f(bfhi(lw[t])) * H1 + bfhi(bw[t]); gv[t] = cvtpk(bflo(gv[t]) * H0, bfhi(gv[t]) * H1); }
#pragma unroll
            for (int t = 0; t < 8; ++t) *(unsigned*)(gates + (row0 + t0 + t) * 2048 + 1024 + 2 * cp) = gv[t];
        }
        if (oh) *(f32x2*)oh = (f32x2){H0, H1};
    }
}

struct FinOut {
    const float* xs; bf16_t* xmb; float* ssrow;
    DI void operator()(int row, int cb, int col, f32x4 sum, int lane) const {
        col = (col & ~31) + dperm(col & 31, 0);
        const size_t m = (size_t)MP + row; const f32x4 v = *(const f32x4*)(xs + (size_t)row * DM + col) + sum;
        u32x2 w; w.x = cvtpk(v[0], v[1]); w.y = cvtpk(v[2], v[3]); *(u32x2*)(xmb + (m + 2) * DM + col) = w;
        float ss = (v[0] * v[0] + v[1] * v[1]) + (v[2] * v[2] + v[3] * v[3]);
        ss += __shfl_xor(ss, 1); ss += __shfl_xor(ss, 2); ss += __shfl_xor(ss, 4); ss += __shfl_xor(ss, 8);
        if ((lane & 15) == 0) (void)__hip_atomic_fetch_add(ssrow + m + 2, ss, __ATOMIC_RELAXED, __HIP_MEMORY_SCOPE_AGENT); }
};
struct FinDown {
    const bf16_t* xmb; float* y;
    DI void operator()(int row, int cb, int col, f32x4 sum, int lane) const { const size_t m = (size_t)MP + row; const u32x2 w = *(const u32x2*)(xmb + (m + 2) * DM + col);
        *(f32x4*)(y + m * DM + col) = (f32x4){bflo(w.x), bfhi(w.x), bflo(w.y), bfhi(w.y)} + sum; }
};
template <int STEPS, class Fin>
DI void small_gemm(Frame& F, const bf16_t* A, int lda, const bf16_t* Bt, int ldb, const Fin& fin) {
    LAS char* lds = (LAS char*)F.lds;
    const int lane = fresh_lane(), wid = F.wave, tid = wid * 64 + lane, l15 = lane & 15, kq = lane >> 4;
    constexpr int NK = STEPS / 2;
    static_assert(STEPS % 2 == 0, "small_gemm k-steps of 32");
    LAS char* sb = lds + wid * 12288;
    const unsigned frd = (unsigned)l15 * 64u + (unsigned)kq * 16u;
#define SG_VMWAIT(n) asm volatile("s_waitcnt vmcnt(" #n ")" ::: "memory")
    for (int u = F.bid; u < (MS / 32) * 16; u += F.G) {
        const int rb = u >> 4, cb = u & 15;
        const bf16_t* ga = A + (size_t)(rb * 32 + (lane >> 2)) * lda + wid * STEPS * 16 + 8 * (lane & 3);
        const bf16_t* gb = Bt + (size_t)(cb * 64 + (lane >> 2)) * ldb + wid * STEPS * 16 + 8 * (lane & 3);
#define SG_ISSUE(ks_, bf_) do { \
        _Pragma("unroll") for (int j_ = 0; j_ < 2; ++j_) __builtin_amdgcn_global_load_lds((const unsigned*)(ga + (size_t)(16 * j_) * lda + (ks_) * 32), (LAS unsigned*)(sb + (bf_) * 6144 + j_ * 1024), 16, 0, 0); \
        _Pragma("unroll") for (int j_ = 0; j_ < 4; ++j_) __builtin_amdgcn_global_load_lds((const unsigned*)(gb + (size_t)(16 * j_) * ldb + (ks_) * 32), (LAS unsigned*)(sb + (bf_) * 6144 + (2 + j_) * 1024), 16, 0, 0); } while (0)
        f32x4 acc[2][4];
#pragma unroll
        for (int i = 0; i < 2; ++i)
#pragma unroll
            for (int j = 0; j < 4; ++j) acc[i][j] = (f32x4){0.f, 0.f, 0.f, 0.f};
        SG_ISSUE(0, 0); if (NK > 1) SG_ISSUE(1, 1);
#pragma unroll
        for (int ks = 0; ks < NK; ++ks) {
            if (ks + 1 < NK) SG_VMWAIT(6); else SG_VMWAIT(0);
            bf16x8 a[2], b[4];
#pragma unroll
            for (int i = 0; i < 2; ++i) a[i] = *(const LAS bf16x8*)(sb + (ks & 1) * 6144 + i * 1024 + frd);
#pragma unroll
            for (int j = 0; j < 4; ++j) b[j] = *(const LAS bf16x8*)(sb + (ks & 1) * 6144 + (2 + j) * 1024 + frd);
            asm volatile("s_waitcnt lgkmcnt(0)" ::: "memory");
            if (ks + 2 < NK) SG_ISSUE(ks + 2, ks & 1);
#pragma unroll
            for (int i = 0; i < 2; ++i)
#pragma unroll
                for (int j = 0; j < 4; ++j) acc[i][j] = __builtin_amdgcn_mfma_f32_16x16x32_bf16(a[i], b[j], acc[i][j], 0, 0, 0);
        }
#undef SG_ISSUE
        __syncthreads();
        LAS float* ob = (LAS float*)lds + wid * 2048;
#pragma unroll
        for (int i = 0; i < 2; ++i)
#pragma unroll
            for (int j = 0; j < 4; ++j)
#pragma unroll
                for (int r = 0; r < 4; ++r) ob[(16 * i + 4 * kq + r) * 64 + 16 * j + l15] = acc[i][j][r];
        __syncthreads();
        { const int row = tid >> 4, c4 = (tid & 15) * 4; f32x4 sum = (f32x4){0.f, 0.f, 0.f, 0.f};
#pragma unroll
          for (int w = 0; w < 8; ++w) sum += *(const LAS f32x4*)((const LAS float*)lds + w * 2048 + row * 64 + c4);
          fin(rb * 32 + row, cb, cb * 64 + c4, sum, lane); }
        __syncthreads();
    }
#undef SG_VMWAIT
}

DI s16x4 vtr(const LAS char* p) { return __builtin_bit_cast(s16x4, __builtin_amdgcn_ds_read_tr16_b64_v4i16((LAS s16x4*)p)); }
constexpr int KCH = 1024;

DI float attn_negb(Frame& F) {
    float mqn = 0.f, mqr = 0.f, mkn = 0.f, mkr = 0.f;
    for (int i = 0; i < 64; ++i) { mqn = fmaxf(mqn, fabsf(F.in(13)[i])); mkn = fmaxf(mkn, fabsf(F.in(15)[i])); }
    for (int i = 0; i < 32; ++i) { mqr = fmaxf(mqr, fabsf(F.in(14)[i])); mkr = fmaxf(mkr, fabsf(F.in(16)[i])); }
    const float bq = sqrtf(64.f * mqn * mqn + 32.f * mqr * mqr), bk = sqrtf(64.f * mkn * mkn + 32.f * mkr * mkr);
    return -(bq * bk * QSCALE * 1.001f);
}

DI void merge_store8(const bf16_t* gates, bf16_t* mix, size_t m, int col, const float* o) {
    const u32x4 ga = *(const u32x4*)(gates + m * 2048 + col), rr = *(const u32x4*)(gates + m * 2048 + 1024 + col);
    u32x4 w;
    w.x = cvtpk(bflo(ga.x) * o[0] + bflo(rr.x), bfhi(ga.x) * o[1] + bfhi(rr.x)); w.y = cvtpk(bflo(ga.y) * o[2] + bflo(rr.y), bfhi(ga.y) * o[3] + bfhi(rr.y));
    w.z = cvtpk(bflo(ga.z) * o[4] + bflo(rr.z), bfhi(ga.z) * o[5] + bfhi(rr.z)); w.w = cvtpk(bflo(ga.w) * o[6] + bflo(rr.w), bfhi(ga.w) * o[7] + bfhi(rr.w));
    *(u32x4*)(mix + m * DM + col) = w;
}

constexpr int A_SLOT = 12288 + 8192, A_NS = 4;
constexpr int A_WSF = A_NS * A_SLOT, A_OST = A_WSF + 2048, A_END = A_OST + 8 * 4096;
static_assert(A_END <= 131072, "attention LDS");
#define VMWAIT(n) asm volatile("s_waitcnt vmcnt(" #n ")" ::: "memory")
DI void attn_prompt_unit(Frame& F, int b, int h, int qb, float negb) {
    LAS char* lds = (LAS char*)F.lds;
    const int lane = fresh_lane(), wid = F.wave, r32 = lane & 31, hi = lane >> 5;
    const bf16_t* KN = (const bf16_t*)(F.out + O_Y); const bf16_t* V = KN + (size_t)MP * DM;
    const bf16_t* KR = (const bf16_t*)(F.ws + WS_KR);
    const size_t rowbase = (size_t)b * PT; const int q0 = qb * 256;
    const bf16_t* Q = q_part(F.ws, rowbase + q0);
    const int NT = (q0 + 256) / 64, cw = (q0 + 32 * wid) / 64;
    const bf16_t* kng = KN + (rowbase + lane) * DM + h * 64 + wid * 8;
    const bf16_t* krg = KR + (rowbase + lane) * ROPE + (wid & 3) * 8;
    const bf16_t* vg = V + (rowbase + 16 * (wid & 3) + (lane >> 2)) * DM + h * 64 + (wid >> 2) * 32 + (lane & 3) * 8;
#define A_DMA(t) do { const int sl_ = ((t) & 3) * A_SLOT; const size_t adv_ = (size_t)(t) * 64; \
        __builtin_amdgcn_global_load_lds((const unsigned*)(kng + adv_ * DM), (LAS unsigned*)(lds + sl_ + wid * KCH), 16, 0, 0); \
        if (wid < 4) __builtin_amdgcn_global_load_lds((const unsigned*)(krg + adv_ * ROPE), (LAS unsigned*)(lds + sl_ + (8 + wid) * KCH), 16, 0, 0); \
        __builtin_amdgcn_global_load_lds((const unsigned*)(vg + adv_ * DM), (LAS unsigned*)(lds + sl_ + 12288 + wid * 1024), 16, 0, 0); } while (0)
    A_DMA(0); if (NT > 1) A_DMA(1); if (NT > 2) A_DMA(2);
    bf16x8 qf[6];
    { const bf16_t* qp = Q + (rowbase + q0 + wid * 32 + r32) * 1536 + h * QKD + 8 * hi;
#pragma unroll
      for (int s = 0; s < 6; ++s) qf[s] = *(const bf16x8*)(qp + 16 * s); }
    f32x16 o0, o1, negm;
#pragma unroll
    for (int r = 0; r < 16; ++r) { o0[r] = 0.f; o1[r] = 0.f; negm[r] = negb; }
    float lsum = 0.f;
    const int vrd = ((lane >> 4) & 1) * 32 + (lane & 3) * 8 + (4 * hi + ((lane & 15) >> 2)) * 64;
    for (int t = 0; t < NT; ++t) {
        { const int rem = NT - 1 - t;
          if (rem >= 2) { if (wid < 4) VMWAIT(6); else VMWAIT(4); }
          else if (rem == 1) { if (wid < 4) VMWAIT(3); else VMWAIT(2); }
          else VMWAIT(0); }
        __builtin_amdgcn_s_barrier(); asm volatile("" ::: "memory");
        if (t + 3 < NT) A_DMA(t + 3);
        if (t <= cw) {
            const LAS char* kb = lds + (t & 3) * A_SLOT + r32 * 16;
            f32x16 p0 = negm, p1 = negm;
#pragma unroll
            for (int s = 0; s < 6; ++s) { const bf16x8 a0 = *(const LAS bf16x8*)(kb + (2 * s + hi) * KCH), a1 = *(const LAS bf16x8*)(kb + (2 * s + hi) * KCH + 512);
                p0 = MFMA32(a0, qf[s], p0); p1 = MFMA32(a1, qf[s], p1); }
            float sacc = 0.f;
#pragma unroll
            for (int r = 0; r < 16; ++r) { p0[r] = __builtin_amdgcn_exp2f(p0[r]); p1[r] = __builtin_amdgcn_exp2f(p1[r]); sacc += p0[r] + p1[r]; }
            lsum += sacc;
            u32x4 pw[4];
#pragma unroll
            for (int e = 0; e < 4; ++e) { pw[0][e] = cvtpk(p0[2 * e], p0[2 * e + 1]); pw[1][e] = cvtpk(p0[8 + 2 * e], p0[8 + 2 * e + 1]); pw[2][e] = cvtpk(p1[2 * e], p1[2 * e + 1]); pw[3][e] = cvtpk(p1[8 + 2 * e], p1[8 + 2 * e + 1]); }
            const LAS char* vb = lds + (t & 3) * A_SLOT + 12288 + vrd;
#pragma unroll
            for (int s2 = 0; s2 < 4; ++s2) {
                const s16x4 l0 = vtr(vb + s2 * 1024), h0 = vtr(vb + s2 * 1024 + 512), l1 = vtr(vb + 4096 + s2 * 1024), h1 = vtr(vb + 4096 + s2 * 1024 + 512);
                const bf16x8 vf0 = __builtin_shufflevector(l0, h0, 0, 1, 2, 3, 4, 5, 6, 7), vf1 = __builtin_shufflevector(l1, h1, 0, 1, 2, 3, 4, 5, 6, 7);
                const bf16x8 pa = __builtin_bit_cast(bf16x8, pw[s2]);
                o0 = MFMA32(pa, vf0, o0); o1 = MFMA32(pa, vf1, o1); }
        }
    }
#undef A_DMA
    lsum += __shfl_xor(lsum, 32);
    LAS float* wsf = (LAS float*)(lds + A_WSF) + wid * 64;
    if (hi == 0) wsf[r32] = lsum;
    LDS_WAIT();
    LAS bf16_t* stg = (LAS bf16_t*)(lds + A_OST) + wid * 2048;
#pragma unroll
    for (int r = 0; r < 16; ++r) { const int orow = crow(r, hi); const float rl = __builtin_amdgcn_rcpf(wsf[orow]);
        stg[orow * 64 + r32] = (bf16_t)(cvtpk(o0[r] * rl, 0.f) & 0xffffu); stg[orow * 64 + 32 + r32] = (bf16_t)(cvtpk(o1[r] * rl, 0.f) & 0xffffu); }
    LDS_WAIT();
    const bf16_t* gates = (const bf16_t*)(F.ws + WS_GATES); bf16_t* mix = (bf16_t*)(F.ws + WS_MIX);
#pragma unroll
    for (int i = 0; i < 4; ++i) { const int row = i * 8 + (lane >> 3), ch = lane & 7; const u32x4 v = *(const LAS u32x4*)(stg + row * 64 + ch * 8);
        const float o[8] = {bflo(v.x), bfhi(v.x), bflo(v.y), bfhi(v.y), bflo(v.z), bfhi(v.z), bflo(v.w), bfhi(v.w)};
        merge_store8(gates, mix, rowbase + q0 + wid * 32 + row, h * 64 + ch * 8, o); }
    __syncthreads();
}

DI void attn_prompt_unit64(Frame& F, int b, int h, int qb2) {
    LAS char* lds = (LAS char*)F.lds;
    const int lane = fresh_lane(), wid = F.wave, r32 = lane & 31, hi = lane >> 5;
    const bf16_t* KN = (const bf16_t*)(F.out + O_Y); const bf16_t* V = KN + (size_t)MP * DM;
    const bf16_t* KR = (const bf16_t*)(F.ws + WS_KR);
    const size_t rowbase = (size_t)b * PT; const int q0 = qb2 * 512;
    const bf16_t* Q = q_part(F.ws, rowbase + q0);
    const int NT = (q0 + 512) / 64, cw = q0 / 64 + wid;
    const bf16_t* kng = KN + (rowbase + lane) * DM + h * 64 + wid * 8;
    const bf16_t* krg = KR + (rowbase + lane) * ROPE + (wid & 3) * 8;
    const bf16_t* vg = V + (rowbase + 16 * (wid & 3) + (lane >> 2)) * DM + h * 64 + (wid >> 2) * 32 + (lane & 3) * 8;
#define A_DMA(t) do { const int sl_ = ((t) & 3) * A_SLOT; const size_t adv_ = (size_t)(t) * 64; \
        __builtin_amdgcn_global_load_lds((const unsigned*)(kng + adv_ * DM), (LAS unsigned*)(lds + sl_ + wid * KCH), 16, 0, 0); \
        if (wid < 4) __builtin_amdgcn_global_load_lds((const unsigned*)(krg + adv_ * ROPE), (LAS unsigned*)(lds + sl_ + (8 + wid) * KCH), 16, 0, 0); \
        __builtin_amdgcn_global_load_lds((const unsigned*)(vg + adv_ * DM), (LAS unsigned*)(lds + sl_ + 12288 + wid * 1024), 16, 0, 0); } while (0)
    A_DMA(0); A_DMA(1); A_DMA(2);
    bf16x8 qf[2][6];
#pragma unroll
    for (int hf = 0; hf < 2; ++hf) { const bf16_t* qp = Q + (rowbase + q0 + wid * 64 + hf * 32 + r32) * 1536 + h * QKD + 8 * hi;
#pragma unroll
        for (int s = 0; s < 6; ++s) qf[hf][s] = *(const bf16x8*)(qp + 16 * s); }
    const f32x16 zero16 = (f32x16){0.f, 0.f, 0.f, 0.f, 0.f, 0.f, 0.f, 0.f, 0.f, 0.f, 0.f, 0.f, 0.f, 0.f, 0.f, 0.f};
    f32x16 o[2][2];
#pragma unroll
    for (int hf = 0; hf < 2; ++hf) { o[hf][0] = zero16; o[hf][1] = zero16; }
    float lsum[2] = {0.f, 0.f};
    const int vrd = ((lane >> 4) & 1) * 32 + (lane & 3) * 8 + (4 * hi + ((lane & 15) >> 2)) * 64;
    for (int t = 0; t < NT; ++t) {
        { const int rem = NT - 1 - t;
          if (rem >= 2) { if (wid < 4) VMWAIT(6); else VMWAIT(4); }
          else if (rem == 1) { if (wid < 4) VMWAIT(3); else VMWAIT(2); }
          else VMWAIT(0); }
        __builtin_amdgcn_s_barrier(); asm volatile("" ::: "memory");
        if (t + 3 < NT) A_DMA(t + 3);
        if (t <= cw) {
            const LAS char* kb = lds + (t & 3) * A_SLOT + r32 * 16;
            f32x16 p[2][2];
#pragma unroll
            for (int s = 0; s < 6; ++s) { const bf16x8 a0 = *(const LAS bf16x8*)(kb + (2 * s + hi) * KCH), a1 = *(const LAS bf16x8*)(kb + (2 * s + hi) * KCH + 512);
#pragma unroll
                for (int hf = 0; hf < 2; ++hf) { p[hf][0] = MFMA32(a0, qf[hf][s], s == 0 ? zero16 : p[hf][0]); p[hf][1] = MFMA32(a1, qf[hf][s], s == 0 ? zero16 : p[hf][1]); } }
            u32x4 pw[2][4];
#pragma unroll
            for (int hf = 0; hf < 2; ++hf) { float sacc = 0.f;
#pragma unroll
                for (int r = 0; r < 16; ++r) { p[hf][0][r] = __builtin_amdgcn_exp2f(p[hf][0][r]); p[hf][1][r] = __builtin_amdgcn_exp2f(p[hf][1][r]); sacc += p[hf][0][r] + p[hf][1][r]; }
                lsum[hf] += sacc;
#pragma unroll
                for (int e = 0; e < 4; ++e) { pw[hf][0][e] = cvtpk(p[hf][0][2 * e], p[hf][0][2 * e + 1]); pw[hf][1][e] = cvtpk(p[hf][0][8 + 2 * e], p[hf][0][8 + 2 * e + 1]);
                    pw[hf][2][e] = cvtpk(p[hf][1][2 * e], p[hf][1][2 * e + 1]); pw[hf][3][e] = cvtpk(p[hf][1][8 + 2 * e], p[hf][1][8 + 2 * e + 1]); } }
            const LAS char* vb = lds + (t & 3) * A_SLOT + 12288 + vrd;
#pragma unroll
            for (int s2 = 0; s2 < 4; ++s2) {
                const s16x4 l0 = vtr(vb + s2 * 1024), h0 = vtr(vb + s2 * 1024 + 512), l1 = vtr(vb + 4096 + s2 * 1024), h1 = vtr(vb + 4096 + s2 * 1024 + 512);
                const bf16x8 vf0 = __builtin_shufflevector(l0, h0, 0, 1, 2, 3, 4, 5, 6, 7), vf1 = __builtin_shufflevector(l1, h1, 0, 1, 2, 3, 4, 5, 6, 7);
#pragma unroll
                for (int hf = 0; hf < 2; ++hf) { const bf16x8 pa = __builtin_bit_cast(bf16x8, pw[hf][s2]); o[hf][0] = MFMA32(pa, vf0, o[hf][0]); o[hf][1] = MFMA32(pa, vf1, o[hf][1]); } }
        }
    }
#undef A_DMA
    const bf16_t* gates = (const bf16_t*)(F.ws + WS_GATES); bf16_t* mix = (bf16_t*)(F.ws + WS_MIX);
    LAS float* wsf = (LAS float*)(lds + A_WSF) + wid * 64;
    LAS bf16_t* stg = (LAS bf16_t*)(lds + A_OST) + wid * 2048;
#pragma unroll
    for (int hf = 0; hf < 2; ++hf) {
        float l = lsum[hf]; l += __shfl_xor(l, 32);
        if (hi == 0) wsf[r32] = l;
        LDS_WAIT();
#pragma unroll
        for (int r = 0; r < 16; ++r) { const int orow = crow(r, hi); const float rl = __builtin_amdgcn_rcpf(wsf[orow]);
            stg[orow * 64 + r32] = (bf16_t)(cvtpk(o[hf][0][r] * rl, 0.f) & 0xffffu); stg[orow * 64 + 32 + r32] = (bf16_t)(cvtpk(o[hf][1][r] * rl, 0.f) & 0xffffu); }
        LDS_WAIT();
#pragma unroll
        for (int i = 0; i < 4; ++i) { const int row = i * 8 + (lane >> 3), ch = lane & 7; const u32x4 v = *(const LAS u32x4*)(stg + row * 64 + ch * 8);
            const float ov[8] = {bflo(v.x), bfhi(v.x), bflo(v.y), bfhi(v.y), bflo(v.z), bfhi(v.z), bflo(v.w), bfhi(v.w)};
            merge_store8(gates, mix, rowbase + q0 + wid * 64 + hf * 32 + row, h * 64 + ch * 8, ov); }
        LDS_WAIT();
    }
    __syncthreads();
}

constexpr int S_WLD = 272;
constexpr int S_W0 = 0, S_OBUF = 128 * S_WLD  , S_LBUF = S_OBUF + 8 * 8192, S_END = S_LBUF + 8 * 128;
DI void attn_sample_unit(Frame& F, int b, int h, float negb) {
    LAS char* lds = (LAS char*)F.lds;
    const int lane = fresh_lane(), wid = F.wave, tid = wid * 64 + lane, r32 = lane & 31, hi = lane >> 5;
    const bf16_t* Q = q_part(F.ws, (size_t)MP); const bf16_t* LAT = (const bf16_t*)(F.ws + WS_LAT); const bf16_t* KR = (const bf16_t*)(F.ws + WS_KR);
    const bf16_t* WN = (const bf16_t*)(F.ws + WS_WKVN) + (size_t)h * 128 * 128;
    for (int i = tid; i < 128 * 16; i += NTHREADS) { const int r = i >> 4, c = i & 15; *(LAS u32x4*)(lds + S_W0 + r * S_WLD + c * 16) = *(const u32x4*)(WN + r * 128 + c * 8); }
    const bf16_t* qp = Q + ((size_t)MP + b * ST + r32) * 1536 + h * QKD;
    const float* gkn = F.in(15);
    bf16x8 qn[4], qr[2];
#pragma unroll
    for (int s = 0; s < 4; ++s) { const u32x2 a = *(const u32x2*)(qp + 16 * s + 4 * hi), c = *(const u32x2*)(qp + 16 * s + 8 + 4 * hi);
        const f32x4 ga = *(const f32x4*)(gkn + 16 * s + 4 * hi), gc = *(const f32x4*)(gkn + 16 * s + 8 + 4 * hi);
        u32x4 w; w.x = cvtpk(bflo(a.x) * ga[0], bfhi(a.x) * ga[1]); w.y = cvtpk(bflo(a.y) * ga[2], bfhi(a.y) * ga[3]); w.z = cvtpk(bflo(c.x) * gc[0], bfhi(c.x) * gc[1]); w.w = cvtpk(bflo(c.y) * gc[2], bfhi(c.y) * gc[3]);
        qn[s] = __builtin_bit_cast(bf16x8, w); }
#pragma unroll
    for (int s = 0; s < 2; ++s) qr[s] = *(const bf16x8*)(qp + 64 + 16 * s + 8 * hi);
    f32x16 o0, o1;
#pragma unroll
    for (int r = 0; r < 16; ++r) { o0[r] = 0.f; o1[r] = 0.f; }
    float lsum = 0.f;
    f32x16 negm;
#pragma unroll
    for (int r = 0; r < 16; ++r) negm[r] = negb;
    __syncthreads();
    const size_t lrow0 = (size_t)MP + (size_t)b * SKEYS;
    const LAS char* wk = lds + S_W0 + r32 * S_WLD + 16 * hi;
    const LAS char* wv = lds + S_W0 + (64 + r32) * S_WLD + 16 * hi;
#define FENCE() asm volatile("" ::: "memory")
    for (int kb = wid; kb < (SKEYS + 31) / 32; kb += NWAVES) {
        const size_t row = lrow0 + (size_t)kb * 32 + r32;
        bf16x8 lf[8], rf[2];
#pragma unroll
        for (int s = 0; s < 8; ++s) lf[s] = *(const bf16x8*)(LAT + row * KVL + 16 * s + 8 * hi);
#pragma unroll
        for (int s = 0; s < 2; ++s) rf[s] = *(const bf16x8*)(KR + row * ROPE + 16 * s + 8 * hi);
        f32x16 kt0 = (f32x16){0.f, 0.f, 0.f, 0.f, 0.f, 0.f, 0.f, 0.f, 0.f, 0.f, 0.f, 0.f, 0.f, 0.f, 0.f, 0.f}, kt1 = kt0;
        { bf16x8 wq0[3], wq1[3];
          wq0[0] = *(const LAS bf16x8*)(wk); wq1[0] = *(const LAS bf16x8*)(wk + 32 * S_WLD); wq0[1] = *(const LAS bf16x8*)(wk + 32); wq1[1] = *(const LAS bf16x8*)(wk + 32 * S_WLD + 32);
#pragma unroll
          for (int s = 0; s < 8; ++s) {
            if (s + 2 < 8) { wq0[(s + 2) % 3] = *(const LAS bf16x8*)(wk + (s + 2) * 32); wq1[(s + 2) % 3] = *(const LAS bf16x8*)(wk + 32 * S_WLD + (s + 2) * 32); }
            kt0 = MFMA32(wq0[s % 3], lf[s], kt0); kt1 = MFMA32(wq1[s % 3], lf[s], kt1);
            FENCE(); } }
        float ss = 0.f;
#pragma unroll
        for (int r = 0; r < 16; ++r) ss += kt0[r] * kt0[r] + kt1[r] * kt1[r];
        ss = xsum32(ss);
        const float rk = __builtin_amdgcn_rsqf(ss * (1.0f / 64.0f) + EPS);
        bf16x8 kf[4];
#pragma unroll
        for (int s = 0; s < 4; ++s) { u32x4 w;
#pragma unroll
            for (int e = 0; e < 4; ++e) { const int r = 8 * (s & 1) + 2 * e; w[e] = (s < 2) ? cvtpk(kt0[r] * rk, kt0[r + 1] * rk) : cvtpk(kt1[r] * rk, kt1[r + 1] * rk); }
            kf[s] = __builtin_bit_cast(bf16x8, w); }
        f32x16 p = negm;
#pragma unroll
        for (int s = 0; s < 4; ++s) p = MFMA32(kf[s], qn[s], p);
        p = MFMA32(rf[0], qr[0], p); p = MFMA32(rf[1], qr[1], p);
        const bool full = (kb * 32 + 32) <= SKEYS;
        float sacc = 0.f;
#pragma unroll
        for (int r = 0; r < 16; ++r) { float e = __builtin_amdgcn_exp2f(p[r]); if (!full && (kb * 32 + crow(r, hi)) >= SKEYS) e = 0.f; p[r] = e; sacc += e; }
        lsum += sacc;
        bf16x8 pf[2];
#pragma unroll
        for (int s2 = 0; s2 < 2; ++s2) { u32x4 pw;
#pragma unroll
            for (int e = 0; e < 4; ++e) { const int r = 8 * s2 + 2 * e; pw[e] = cvtpk(p[r], p[r + 1]); }
            pf[s2] = __builtin_bit_cast(bf16x8, pw); }
        FENCE();
        f32x16 v0 = (f32x16){0.f, 0.f, 0.f, 0.f, 0.f, 0.f, 0.f, 0.f, 0.f, 0.f, 0.f, 0.f, 0.f, 0.f, 0.f, 0.f}, v1 = v0;
        { bf16x8 wq0[3], wq1[3];
          wq0[0] = *(const LAS bf16x8*)(wv); wq1[0] = *(const LAS bf16x8*)(wv + 32 * S_WLD); wq0[1] = *(const LAS bf16x8*)(wv + 32); wq1[1] = *(const LAS bf16x8*)(wv + 32 * S_WLD + 32);
#pragma unroll
          for (int s = 0; s < 8; ++s) {
            if (s + 2 < 8) { wq0[(s + 2) % 3] = *(const LAS bf16x8*)(wv + (s + 2) * 32); wq1[(s + 2) % 3] = *(const LAS bf16x8*)(wv + 32 * S_WLD + (s + 2) * 32); }
            v0 = MFMA32(lf[s], wq0[s % 3], v0); v1 = MFMA32(lf[s], wq1[s % 3], v1);
            FENCE(); } }
#pragma unroll
        for (int s2 = 0; s2 < 2; ++s2) { u32x4 vw0, vw1;
#pragma unroll
            for (int e = 0; e < 4; ++e) { const int r = 8 * s2 + 2 * e; vw0[e] = cvtpk(v0[r], v0[r + 1]); vw1[e] = cvtpk(v1[r], v1[r + 1]); }
            o0 = MFMA32(pf[s2], __builtin_bit_cast(bf16x8, vw0), o0); o1 = MFMA32(pf[s2], __builtin_bit_cast(bf16x8, vw1), o1); }
        FENCE();
    }
    lsum += __shfl_xor(lsum, 32);
    LAS float* ob = (LAS float*)(lds + S_OBUF) + wid * 2048; LAS float* lb = (LAS float*)(lds + S_LBUF) + wid * 32;
    if (hi == 0) lb[r32] = lsum;
#pragma unroll
    for (int r = 0; r < 16; ++r) { const int q = crow(r, hi); ob[q * 64 + r32] = o0[r]; ob[q * 64 + 32 + r32] = o1[r]; }
    __syncthreads();
    if (tid < 256) { const int q = tid >> 3, c8 = (tid & 7) * 8; float o[8], l = 0.f;
#pragma unroll
        for (int i = 0; i < 8; ++i) o[i] = 0.f;
#pragma unroll
        for (int w = 0; w < 8; ++w) { const LAS float* p = (const LAS float*)(lds + S_OBUF) + w * 2048 + q * 64 + c8; const f32x4 a = *(const LAS f32x4*)p, c = *(const LAS f32x4*)(p + 4);
            o[0] += a[0]; o[1] += a[1]; o[2] += a[2]; o[3] += a[3]; o[4] += c[0]; o[5] += c[1]; o[6] += c[2]; o[7] += c[3]; l += ((const LAS float*)(lds + S_LBUF))[w * 32 + q]; }
        const float rl = 1.0f / l;
#pragma unroll
        for (int i = 0; i < 8; ++i) o[i] *= rl;
        merge_store8((const bf16_t*)(F.ws + WS_GATES), (bf16_t*)(F.ws + WS_MIX), (size_t)MP + b * ST + q, h * 64 + c8, o); }
    __syncthreads();
}

DI void p7_attention(Frame& F) {
    const float negb = attn_negb(F);
#ifndef NO_SAMPLE
    for (int u0 = F.bid; u0 < SB * NH; u0 += F.G) { const int u = (F.G == 256) ? (u0 & 7) * 32 + (u0 >> 3) : u0; attn_sample_unit(F, u >> 4, u & 15, negb); }
#endif
#ifndef NO_PROMPT
    if (F.G == 256 && negb > -96.0f) {
        const int g = F.bid >> 6, bh = F.bid & 63;
        attn_prompt_unit64(F, bh >> 4, bh & 15, 7 - g); attn_prompt_unit64(F, bh >> 4, bh & 15, g);
    } else {
        for (int L = F.bid; L < PB * NH * 16; L += F.G) attn_prompt_unit(F, (L & 63) >> 4, L & 15, 15 - (L >> 6), negb);
    }
#endif
}


#define XB_TMO      128
#define XB_XCNT(j)  (256  + 64 * (j))
#define XB_XSUB(j)  (1280 + 64 * (j))
#define XB_XGEN(j)  (2304 + 64 * (j))
#define XB_TOP      3328
#define XB_TOPGEN   3392
#define XCD_BAR_WORDS 3456
#define XB_SPIN_CAP (1u << 22)
DI unsigned xb_ld(unsigned* p)              { return __hip_atomic_load(p, __ATOMIC_RELAXED, __HIP_MEMORY_SCOPE_AGENT); }
DI unsigned xb_add(unsigned* p, unsigned v) { return __hip_atomic_fetch_add(p, v, __ATOMIC_RELAXED, __HIP_MEMORY_SCOPE_AGENT); }
DI unsigned xb_xcc_id() { return (unsigned)__builtin_amdgcn_s_getreg((3 << 11) | 20) & 0xFu; }
#define XB_SPIN(cond, bar) do { unsigned _sp = 0; while (cond) { __builtin_amdgcn_s_sleep(1); \
    if ((++_sp & 255u) == 0u) { if (xb_ld(&(bar)[XB_TMO])) break; if (_sp > XB_SPIN_CAP) { atomicAdd(&(bar)[XB_TMO], 1u); break; } } } } while (0)
struct XcdBarrier { unsigned* bar; unsigned x; volatile LAS unsigned* st; };
DI XcdBarrier xcd_barrier_post(unsigned* bar, volatile LAS unsigned* st, bool leader) {
    XcdBarrier b; b.bar = bar; b.x = xb_xcc_id(); b.st = st;
    if (leader) (void)xb_add(&bar[XB_XCNT(b.x)], 1u);
    return b;
}
DI void xcd_barrier_complete(unsigned* bar, unsigned x, unsigned G, unsigned& nloc, unsigned& nx) {
    unsigned sum, cnt, mine, sp = 0u;
    for (;;) {
        sum = 0u; cnt = 0u; mine = 0u;
#pragma unroll
        for (unsigned j = 0; j < 16; ++j) { const unsigned c = xb_ld(&bar[XB_XCNT(j)]); sum += c; cnt += (c > 0u) ? 1u : 0u; mine = (j == x) ? c : mine; }
        if (sum == G) break;
        __builtin_amdgcn_s_sleep(1);
        if ((++sp & 255u) == 0u) { if (xb_ld(&bar[XB_TMO])) break; if (sp > XB_SPIN_CAP) { atomicAdd(&bar[XB_TMO], 1u); break; } }
    }
    nloc = mine > 0u ? mine : 1u; nx = cnt > 0u ? cnt : 1u;
}
DI void xcd_barrier(const XcdBarrier& b, unsigned G, int wave) {
    asm volatile("s_waitcnt vmcnt(0)" ::: "memory");
    __syncthreads();
    if (wave == 0 && fresh_lane() == 0) {
        unsigned* bar = b.bar;
        __builtin_amdgcn_s_waitcnt(0);
        unsigned nloc = b.st[0], nx = b.st[1];
        if (nloc == 0u) { xcd_barrier_complete(bar, b.x, G, nloc, nx); b.st[0] = nloc; b.st[1] = nx; }
        const unsigned old = xb_add(&bar[XB_XSUB(b.x)], 1u);
        const unsigned gen = old / nloc;
        if (old + 1u == (gen + 1u) * nloc) {
            __builtin_amdgcn_fence(__ATOMIC_RELEASE, "agent");
            asm volatile("s_waitcnt vmcnt(0)" ::: "memory");
            const unsigned og = xb_add(&bar[XB_TOP], 1u);
            const unsigned tg = og / nx;
            if (og + 1u == (tg + 1u) * nx) xb_add(&bar[XB_TOPGEN], 1u);
            else XB_SPIN(xb_ld(&bar[XB_TOPGEN]) == tg, bar);
            __builtin_amdgcn_fence(__ATOMIC_ACQUIRE, "agent");
            xb_add(&bar[XB_XGEN(b.x)], 1u);
            asm volatile("s_waitcnt vmcnt(0)" ::: "memory");
        } else {
            XB_SPIN(xb_ld(&bar[XB_XGEN(b.x)]) == gen, bar);
            __builtin_amdgcn_fence(__ATOMIC_ACQUIRE, "agent");
            asm volatile("s_waitcnt vmcnt(0)" ::: "memory");
        }
    }
    __syncthreads();
}

__global__ void __launch_bounds__(NTHREADS, 2) hybrid_fwd(Args args) {
    extern __shared__ __attribute__((aligned(16))) unsigned char lds_raw[];
    Frame F;
    F.lds = (LAS unsigned char*)lds_raw; F.wave = __builtin_amdgcn_readfirstlane(threadIdx.x >> 6);
    F.G = gridDim.x; F.bid = blockIdx.x; F.ws = args.ws; F.out = args.out;
    unsigned char* ws = args.ws;
    if (threadIdx.x < 30) ((LAS unsigned long long*)(F.lds + RING_BYTES))[threadIdx.x] = (unsigned long long)args.in[threadIdx.x];
    __syncthreads();
    const int lo = args.ph_lo, hi = args.ph_hi;
    if (threadIdx.x < 8) ((LAS unsigned*)(F.lds + RING_BYTES + 256))[threadIdx.x] = 0u;
    __syncthreads();
    const XcdBarrier bar = xcd_barrier_post((unsigned*)(ws + WS_CTL) + 1024, (volatile LAS unsigned*)(F.lds + RING_BYTES + 256), threadIdx.x == 0);
#ifndef PH_MASK
#define PH_MASK 0xFFFF
#endif
#define IN(k) (((PH_MASK >> (k)) & 1) && lo <= (k) && (k) < hi)
#define SEAM(k) do { if (IN(k) && IN((k) + 1)) xcd_barrier(bar, (unsigned)gridDim.x, F.wave); } while (0)
    const int bid = (int)blockIdx.x, G = (int)gridDim.x;

    if (IN(0)) { p0_prologue(F); } SEAM(0);
    if (IN(1)) {
        pg8::Gemm g{(const bf16_t*)(ws + WS_XN), (const bf16_t*)(ws + WS_WIN), 1024, 1024, 1024, 0, 1, 0, MT / 256, 14};
        pg8::StaticOrder S; S.init(g.nM, g.nN, G, bid);
        EpiIn E{(bf16_t*)(ws + WS_CQN), (float*)(ws + WS_SSCQ), (bf16_t*)(args.out + O_Y), (bf16_t*)(ws + WS_GATES), F.in(11), F.in(16), (const f32x2*)(ws + WS_TAB), args.out, (bf16_t*)(ws + WS_LAT), (bf16_t*)(ws + WS_KR)};
        pg8::gemm_phase<0>(F.lds, F.wave, g, S, E);
        { const int first = (g.nM * g.nN) % G;
          if (first != 0 && bid >= first) { late_weights(F, (bid - first) * NWAVES + F.wave, (G - first) * NWAVES, 0, G == 256 ? LATE_DOWN0 : LATE_ITEMS);
              if (G == 256) cache_convert(F, (bid - first) * NTHREADS + F.wave * 64 + fresh_lane(), (G - first) * NTHREADS, CACHE_P0, SB - CACHE_LATE); }
          else if (first == 0) late_weights(F, bid * NWAVES + F.wave, G * NWAVES, 0, LATE_ITEMS); }
    } SEAM(1);
    if (IN(2)) {
        pg8::Gemm g{(const bf16_t*)(ws + WS_UC), (const bf16_t*)(ws + WS_WLRU), 1024, 128, 128, 128, 1, 0, MP / 256, 8};
        pg8::StaticOrder S; S.init(g.nM, g.nN, G, bid);
        EpiLru E{(const bf16_t*)(ws + WS_UC), F.in(20), F.in(22), (const float*)(ws + WS_SP8), (bf16_t*)(ws + WS_LA), (bf16_t*)(ws + WS_BT)};
        conv_own_units(F, S);
        pg8::gemm_phase<0>(F.lds, F.wave, g, S, E);
        scan_local_own(F, S);
        lru_small(F);
    } SEAM(2);
    if (IN(3)) {
        p5_scan_apply(F);
        { pg8::Gemm g{(const bf16_t*)(ws + WS_CQN), (const bf16_t*)(ws + WS_WQB), 256, 256, 256, 0, 1, 0, MT / 256, 6};
          pg8::StaticOrder S; S.init(g.nM, g.nN, G, bid);
          EpiQ E{ws, F.in(13), F.in(14), (const f32x2*)(ws + WS_TAB), (const float*)(ws + WS_SSCQ)};
          pg8::gemm_phase<0>(F.lds, F.wave, g, S, E); }
        { pg8::Gemm g{(const bf16_t*)(ws + WS_LAT), (const bf16_t*)(ws + WS_WKVB), 128, 128, 128, 0, 1, 0, MP / 256, 8};
          pg8::StaticOrder S; S.init(g.nM, g.nN, G, (bid + 144) % G);
          EpiKV E{(bf16_t*)(args.out + O_Y), (bf16_t*)(args.out + O_Y) + (size_t)MP * DM, F.in(15)};
          pg8::gemm_phase<0>(F.lds, F.wave, g, S, E); }
        if (G == 256 && bid >= SCAN_EXTRA0 + 16) { constexpr int LIGHT0 = SCAN_EXTRA0 + 16; cache_convert(F, (bid - LIGHT0) * NTHREADS + F.wave * 64 + fresh_lane(), (256 - LIGHT0) * NTHREADS, SB - CACHE_LATE, SB); }
    } SEAM(3);
    if (IN(4)) { p7_attention(F); } SEAM(4);
    if (IN(5)) {
        { pg8::Gemm g{(const bf16_t*)(ws + WS_MIX), (const bf16_t*)(ws + WS_WOUT), 1024, 1024, 1024, 0, 1, 0, MP / 256, 4};
          pg8::StaticOrder S; S.init(g.nM, g.nN, G, bid);
          EpiOut E{F.in(0), (bf16_t*)(ws + WS_XMB), (float*)(ws + WS_SSROW)};
          pg8::gemm_phase<0>(F.lds, F.wave, g, S, E); }
        { FinOut fin{F.in(1), (bf16_t*)(ws + WS_XMB), (float*)(ws + WS_SSROW)};
          small_gemm<DM / 128>(F, (const bf16_t*)(ws + WS_MIX) + (size_t)MP * DM, DM, (const bf16_t*)(ws + WS_WOUT), DM, fin); }
    } SEAM(5);
    if (IN(6)) {
        static_assert(EpiUp<true>::N_FAST + EpiUp<true>::N_SLOW == (MT + 247) / 248, "row tiles of the up projection");
        { pg8::Gemm g{(const bf16_t*)(ws + WS_XMB) + 2 * DM, (const bf16_t*)(ws + WS_WUP), 1024, 1024, 1024, 0, 1, 0, EpiUp<true>::N_FAST, 22};
          pg8::StaticOrder S; S.init(g.nM, g.nN, G, bid);
          EpiUp<true> E{(const float*)(ws + WS_SSROW), (const float*)(ws + WS_CWS), F.in(6), (bf16_t*)(ws + WS_HFF), args.out + O_PFFN, args.out + O_SFFN};
          pg8::gemm_phase<2>(F.lds, F.wave, g, S, E); }
        { pg8::Gemm g{(const bf16_t*)(ws + WS_XMB) + 2 * DM, (const bf16_t*)(ws + WS_WUP), 1024, 1024, 1024, 0, 1, 0, EpiUp<false>::N_SLOW, 22};
          const int first = (EpiUp<true>::N_FAST * 22) % G;
          pg8::StaticOrder S; S.init(g.nM, g.nN, G, (bid - first + G) % G);
          EpiUp<false> E{(const float*)(ws + WS_SSROW), (const float*)(ws + WS_CWS), F.in(6), (bf16_t*)(ws + WS_HFF), args.out + O_PFFN, args.out + O_SFFN};
          pg8::gemm_phase<2>(F.lds, F.wave, g, S, E);
          constexpr int NSLOW = EpiUp<false>::N_SLOW * 22;
          if (G == 256) { const int c = (bid - first + G) % G; if (c >= NSLOW && bid >= first) late_weights(F, (c - NSLOW) * NWAVES + F.wave, (G - first - NSLOW) * NWAVES, LATE_DOWN0, LATE_ITEMS); } }
    } SEAM(6);
    if (IN(7)) {
        { pg8::Gemm g{(const bf16_t*)(ws + WS_HFF), (const bf16_t*)(ws + WS_WDOWN), DFF, DFF, DFF, 0, 1, 0, MP / 256, 4};
          pg8::StaticOrder S; S.init(g.nM, g.nN, G, bid);
          EpiDown E{(const bf16_t*)(ws + WS_XMB), args.out + O_Y};
          pg8::gemm_phase<0>(F.lds, F.wave, g, S, E); }
        { FinDown fin{(const bf16_t*)(ws + WS_XMB), args.out + O_Y};
          small_gemm<DFF / 128>(F, (const bf16_t*)(ws + WS_HFF) + (size_t)MP * DFF, DFF, (const bf16_t*)(ws + WS_WDOWN), DFF, fin); }
    }
#undef IN
#undef SEAM
}

extern "C" void kernel_launch(void* const* d_in, const int* in_sizes, int n_in, void* d_out, int out_size, void* d_ws, size_t ws_size, hipStream_t stream) {
    static int grid = 0;
    if (grid == 0) {
        if (n_in != 30 || out_size != (int)O_END || ws_size < WS_END) { fprintf(stderr, "kernel_launch: unexpected problem (n_in %d out %d ws %zu)\n", n_in, out_size, ws_size); grid = -1; return; }
        int dev = 0, cus = 0, per_cu = 0;
        hipGetDevice(&dev); hipDeviceGetAttribute(&cus, hipDeviceAttributeMultiprocessorCount, dev);
        if (hipFuncSetAttribute((const void*)hybrid_fwd, hipFuncAttributeMaxDynamicSharedMemorySize, LDS_BYTES) != hipSuccess) { fprintf(stderr, "kernel_launch: hipFuncSetAttribute failed\n"); grid = -1; return; }
        if (hipOccupancyMaxActiveBlocksPerMultiprocessor(&per_cu, (const void*)hybrid_fwd, NTHREADS, LDS_BYTES) != hipSuccess || per_cu < 1) { fprintf(stderr, "kernel_launch: occupancy query says %d\n", per_cu); per_cu = 1; }
        (void)hipGetLastError();
        grid = cus;
    }
    if (grid < 0) return;
    if (hipMemsetAsync((char*)d_ws + WS_CTL, 0, CTL_BYTES, stream) != hipSuccess) { fprintf(stderr, "kernel_launch: memset failed\n"); return; }
    Args a{};
    for (int i = 0; i < 30; ++i) a.in[i] = (const float*)d_in[i];
    a.out = (float*)d_out; a.ws = (unsigned char*)d_ws;
#if MK_LAUNCHES == 1
    a.ph_lo = 0; a.ph_hi = N_PHASES;
    void* kargs[] = {&a};
    hipError_t e = hipLaunchCooperativeKernel((const void*)hybrid_fwd, dim3(grid), dim3(NTHREADS), kargs, LDS_BYTES, stream);
    if (e != hipSuccess) fprintf(stderr, "kernel_launch: cooperative launch failed: %s (grid %d)\n", hipGetErrorString(e), grid);
#else
    for (int p = 0; p < N_PHASES; ++p) { a.ph_lo = p; a.ph_hi = p + 1; hipLaunchKernelGGL(hybrid_fwd, dim3(grid), dim3(NTHREADS), LDS_BYTES, stream, a); }
#endif
}
```

```cpp
#include <hip/hip_runtime.h>
#include <cstdio>
#include <cstdint>

#ifndef MK_LAUNCHES
#define MK_LAUNCHES 1
#endif

#define LAS __attribute__((address_space(3)))
#define DI __device__ __forceinline__
typedef unsigned short bf16_t;
typedef short bf16x8 __attribute__((ext_vector_type(8)));
typedef short s16x4 __attribute__((ext_vector_type(4)));
typedef float f32x4 __attribute__((ext_vector_type(4)));
typedef float f32x2 __attribute__((ext_vector_type(2)));
typedef float f32x16 __attribute__((ext_vector_type(16)));
typedef unsigned u32x4 __attribute__((ext_vector_type(4)));
typedef unsigned u32x2 __attribute__((ext_vector_type(2)));
typedef __bf16 bf16x2_t __attribute__((ext_vector_type(2)));

constexpr int DM = 1024, PB = 4, PT = 4096, SB = 16, ST = 32, PAST = 4096;
constexpr int MP = PB * PT, MS = SB * ST, MT = MP + MS;
constexpr int NH = 16, QL = 256, KVL = 128, NOPE = 64, ROPE = 32, QKD = 96;
constexpr int DFF = 2816, NUP = 2 * DFF;
constexpr int SKEYS = PAST + ST;
constexpr int LROWS = MP + SB * SKEYS;
constexpr float EPS = 1e-6f;
constexpr float LOG2E = 1.4426950408889634f;
constexpr float QSCALE = 0.10206207261596577f * LOG2E;
constexpr int ZQW = 416;

constexpr size_t MiB = 1u << 20;
constexpr size_t WS_CTL = 0, CTL_BYTES = 64 * 1024;
constexpr size_t WS_TAB = 1 * MiB;
constexpr size_t WS_SP8 = 1 * MiB + 768 * 1024;
constexpr size_t WS_SSCQ = 1 * MiB + 896 * 1024;
constexpr size_t WS_SSROW = 2 * MiB;
constexpr size_t WS_CWS = 3 * MiB;
constexpr size_t WS_AGG = 4 * MiB;
constexpr size_t WS_WIN = 6 * MiB;
constexpr size_t WS_WQB = 13 * MiB;
constexpr size_t WS_WKVB = 13 * MiB + 768 * 1024;
constexpr size_t WS_WKVN = 14 * MiB + 256 * 1024;
constexpr size_t WS_WLRU = 14 * MiB + 768 * 1024;
constexpr size_t WS_WOUT = 15 * MiB + 512 * 1024;
constexpr size_t WS_WUP = 17 * MiB + 512 * 1024;
constexpr size_t WS_WDOWN = 28 * MiB + 512 * 1024;
constexpr size_t WS_LAT = 34 * MiB;
constexpr size_t WS_KR = 54 * MiB + 512 * 1024;
constexpr size_t WS_GATES = 60 * MiB;
constexpr size_t WS_XN = 126 * MiB;
constexpr size_t WS_ZQ = 159 * MiB;
constexpr size_t WS_CQN = 228 * MiB;
constexpr size_t WS_UC = 126 * MiB;
constexpr size_t WS_LA = 159 * MiB;
constexpr size_t WS_BT = 192 * MiB;
constexpr size_t WS_Q1 = 126 * MiB;
constexpr size_t WS_Q2 = 237 * MiB;
constexpr int QSPLIT = 11264;
constexpr size_t WS_MIX = 192 * MiB;
constexpr size_t WS_XMB = 126 * MiB;
constexpr size_t WS_HFF = 160 * MiB;
constexpr size_t WS_END = 254 * MiB;
constexpr int XMB_ROWS = 17152;

constexpr size_t O_Y = 0;
constexpr size_t O_PLAT = (size_t)MT * DM;
constexpr size_t O_PKR = O_PLAT + (size_t)MP * KVL;
constexpr size_t O_PH = O_PKR + (size_t)MP * ROPE;
constexpr size_t O_PCONV = O_PH + (size_t)PB * DM;
constexpr size_t O_PFFN = O_PCONV + (size_t)PB * 3 * DM;
constexpr size_t O_SLAT = O_PFFN + (size_t)PB * 2 * NUP;
constexpr size_t O_SKR = O_SLAT + (size_t)MS * KVL;
constexpr size_t O_SH = O_SKR + (size_t)MS * ROPE;
constexpr size_t O_SCONV = O_SH + (size_t)SB * DM;
constexpr size_t O_SFFN = O_SCONV + (size_t)SB * 3 * DM;
constexpr size_t O_END = O_SFFN + (size_t)SB * 2 * NUP;
static_assert(O_END == 20312064, "output size");

DI unsigned cvtpk(float lo, float hi) { f32x2 v = {lo, hi}; bf16x2_t b = __builtin_convertvector(v, bf16x2_t); return __builtin_bit_cast(unsigned, b); }
DI float bf2f(unsigned short b) { return __uint_as_float((unsigned)b << 16); }
DI float bflo(unsigned w) { return __uint_as_float(w << 16); }
DI float bfhi(unsigned w) { return __uint_as_float(w & 0xffff0000u); }
DI float wave_sum(float v) {
#pragma unroll
    for (int o = 1; o < 64; o <<= 1) v += __shfl_xor(v, o);
    return v;
}
DI int fresh_lane() { int l; asm volatile("v_mbcnt_lo_u32_b32 %0, -1, 0\n\tv_mbcnt_hi_u32_b32 %0, -1, %0" : "=v"(l)); return l; }
DI float bperm(int byteaddr, float v) { return __int_as_float(__builtin_amdgcn_ds_bpermute(byteaddr, __float_as_int(v))); }
template <int CTRL> DI float dpp_mov(float v) { return __int_as_float(__builtin_amdgcn_update_dpp(0, __float_as_int(v), CTRL, 0xf, 0xf, false)); }
DI float sigmoidf_(float x) { return __builtin_amdgcn_rcpf(1.0f + __expf(-x)); }
DI float xsum32(float x) { const auto r = __builtin_amdgcn_permlane32_swap(__float_as_uint(x), __float_as_uint(x), false, false); return __uint_as_float(r[0]) + __uint_as_float(r[1]); }
DI float xsum16(float x) { const auto r = __builtin_amdgcn_permlane16_swap(__float_as_uint(x), __float_as_uint(x), false, false); return __uint_as_float(r[0]) + __uint_as_float(r[1]); }
DI float rowsum4(float x) { return xsum32(xsum16(x)); }
#define SG2(x) __builtin_amdgcn_rcpf(1.0f + __builtin_amdgcn_exp2f(x))
DI bf16_t* q_part(unsigned char* ws, size_t row) { return row < (size_t)QSPLIT ? (bf16_t*)(ws + WS_Q1) : (bf16_t*)(ws + WS_Q2) - (size_t)QSPLIT * 1536; }
DI int row_pos(int m) { return m < MP ? (m & (PT - 1)) : PAST + ((m - MP) & (ST - 1)); }
DI int lat_row(int m) { if (m < MP) return m; const int ms = m - MP; return MP + (ms >> 5) * SKEYS + PAST + (ms & 31); }
#define LDS_WAIT() asm volatile("s_waitcnt lgkmcnt(0)" ::: "memory")
DI int crow(int r, int hi) { return (r & 3) + 8 * (r >> 2) + 4 * hi; }
#define MFMA32(a, b, c) __builtin_amdgcn_mfma_f32_32x32x16_bf16((a), (b), (c), 0, 0, 0)

namespace pg8 {
constexpr int BM = 256, BK = 64, HALF = 128, HTB = HALF * BK * 2, STAGE_BYTES = 8 * HTB, NXCD = 8, WGM = 8;
__host__ __device__ __forceinline__ int lds_byte(int r, int c) { const int st = (r >> 4) * 2 + (c >> 5), rr = r & 15, cc = c & 31, ob = rr * 64 + cc * 2; return st * 1024 + (ob ^ (((ob >> 9) & 1) << 5)); }
__host__ __device__ __forceinline__ void stage_rc(int b, int& R, int& C) { const int st = b / 1024, sb = b % 1024, swz = sb ^ (((sb >> 9) & 1) << 5); R = (st >> 1) * 16 + swz / 64; C = (st & 1) * 32 + (swz % 64) / 2; }

struct Unit { int pm, pn; };
struct Gemm { const bf16_t* A; const bf16_t* Bt; int lda, ldb, K, acoln, ks, kcol, nM, nN; };

struct StaticOrder {
    int nM, nN, nwg, G, c;
    DI void init(int nM_, int nN_, int G_, int c_) { nM = nM_; nN = nN_; nwg = nM * nN; G = G_; c = c_; }
    DI bool next(int i, Unit& u) const {
        const long L = (long)i * G + c; if (L >= nwg) return false;
        int wgid = (int)L; { const int q = nwg / NXCD, r = nwg % NXCD, xcd = wgid % NXCD, off = wgid / NXCD; wgid = (xcd < r ? xcd * (q + 1) : r * (q + 1) + (xcd - r) * q) + off; }
        const int nig = WGM * nN, gid = wgid / nig, fm = gid * WGM, gsz = (nM - fm) < WGM ? (nM - fm) : WGM;
        u.pm = fm + ((wgid % nig) % gsz); u.pn = (wgid % nig) / gsz; return true;
    }
};

template <class Epi> struct RowPerm { static constexpr bool v = false; };
template <int OV, class Epi>
DI void gemm_phase(LAS unsigned char* lds, const int wid, const Gemm g, const StaticOrder& S, const Epi& E) {
    const int wr = wid >> 2, wc = wid & 3;
    int K = g.K; asm volatile("" : "+s"(K));
    const int nt = K / BK;
    unsigned voffA[2], voffB[2]; int aoff, boff;
#define PG8_LANE_STATE() do { const int lane_ = fresh_lane(), tid_ = wid * 64 + lane_, fr_ = lane_ & 15, fq_ = lane_ >> 4; \
        _Pragma("unroll") for (int i = 0; i < 2; ++i) { int R, C; stage_rc(tid_ * 16 + i * 8192, R, C); \
            const int Ra_ = RowPerm<Epi>::v ? ((R & ~63) | (4 * (R & 15) + ((R >> 4) & 3))) : R; \
            voffA[i] = (unsigned)((Ra_ - OV * (Ra_ >> 6)) * g.lda + C) * 2u; voffB[i] = (unsigned)(R * g.ldb + C) * 2u; } \
        aoff = lds_byte(wr * 64 + fr_, fq_ * 8); boff = lds_byte(wc * 32 + fr_, fq_ * 8); } while (0)
    PG8_LANE_STATE();
    const size_t kstep = (size_t)(BK * 2);
    const size_t hstepA = (size_t)(HALF - 2 * OV) * g.lda * 2, hstepB = (size_t)HALF * g.ldb * 2;
    const size_t tstepA = 2 * hstepA, tstepB = 2 * hstepB;
    const unsigned ldsw = (unsigned)wid * 1024u;
#define PG8_SA(b, h) (((b) * 2 + (h)) * HTB)
#define PG8_SB(b, h) ((4 + (b) * 2 + (h)) * HTB)
#define PG8_STAGE(bufoff, gbase, voff) do { _Pragma("unroll") for (int _i = 0; _i < 2; ++_i) \
        __builtin_amdgcn_global_load_lds((const unsigned*)((const char*)(gbase) + (voff)[_i]), (LAS unsigned*)(lds + (bufoff) + ldsw + _i * 8192), 16, 0, 0); } while (0)
#define PG8_LDA(dst, b, h) do { _Pragma("unroll") for (int m = 0; m < 4; ++m) _Pragma("unroll") for (int k = 0; k < 2; ++k) dst[m][k] = *(const LAS bf16x8*)(lds + PG8_SA(b, h) + aoff + m * 2048 + k * 1024); } while (0)
#define PG8_LDB(dst, b, h) do { _Pragma("unroll") for (int n = 0; n < 2; ++n) _Pragma("unroll") for (int k = 0; k < 2; ++k) dst[n][k] = *(const LAS bf16x8*)(lds + PG8_SB(b, h) + boff + n * 2048 + k * 1024); } while (0)
#define PG8_MMA(ai, bj, At, Bt) do { __builtin_amdgcn_s_setprio(1); _Pragma("unroll") for (int m = 0; m < 4; ++m) _Pragma("unroll") for (int n = 0; n < 2; ++n) _Pragma("unroll") for (int k = 0; k < 2; ++k) \
        acc[ai][bj][m][n] = __builtin_amdgcn_mfma_f32_16x16x32_bf16(Bt[n][k], At[m][k], acc[ai][bj][m][n], 0, 0, 0); __builtin_amdgcn_s_setprio(0); } while (0)
#define PG8_WAIT_V(n) asm volatile("s_waitcnt vmcnt(" #n ")" ::: "memory")
#define PG8_WAIT_L(n) asm volatile("s_waitcnt lgkmcnt(" #n ")" ::: "memory")
#define PG8_BAR __builtin_amdgcn_s_barrier()
#define PG8_SCHED __builtin_amdgcn_sched_barrier(0)
#define PG8_ABASE(u) ((const char*)g.A + ((long)Epi::rowtile((u).pm) * (BM - 4 * OV) - OV) * (long)g.lda * 2 + (long)(((u).pn / g.ks) * g.acoln + ((u).pn % g.ks) * g.kcol) * 2)
#define PG8_BBASE(u) ((const char*)g.Bt + (size_t)((u).pn / g.ks) * tstepB + (size_t)(((u).pn % g.ks) * g.kcol) * 2)
    Unit cur, nxt; int ui = 0;
    if (!S.next(0, cur)) return;
    E.prefetch(lds, wid, Epi::rowtile(cur.pm), cur.pn / g.ks, 0);
    f32x4 acc[2][2][4][2];
#pragma unroll
    for (int a = 0; a < 2; ++a)
#pragma unroll
        for (int b = 0; b < 2; ++b)
#pragma unroll
            for (int m = 0; m < 4; ++m)
#pragma unroll
                for (int n = 0; n < 2; ++n) acc[a][b][m][n] = (f32x4){0.f, 0.f, 0.f, 0.f};
    bf16x8 At[4][2], B0[2][2], B1[2][2];
    const char* cA = PG8_ABASE(cur); const char* cB = PG8_BBASE(cur);
    PG8_STAGE(PG8_SB(0, 0), cB, voffB); PG8_STAGE(PG8_SB(0, 1), cB + hstepB, voffB); PG8_STAGE(PG8_SA(0, 0), cA, voffA); PG8_STAGE(PG8_SA(0, 1), cA + hstepA, voffA);
    if (wr == 1) PG8_BAR;
    PG8_WAIT_V(2); PG8_BAR;
    PG8_STAGE(PG8_SB(1, 0), cB + kstep, voffB); PG8_STAGE(PG8_SA(1, 0), cA + kstep, voffA); PG8_STAGE(PG8_SB(1, 1), cB + hstepB + kstep, voffB);
    PG8_WAIT_V(6); PG8_BAR;
    for (;;) {
        const bool has_next = S.next(ui + 1, nxt);
        const char* nA = has_next ? PG8_ABASE(nxt) : cA; const char* nB = has_next ? PG8_BBASE(nxt) : cB;
        for (int t = 0; t < nt; t += 2) {
            const bool last = (t == nt - 2);
            const char* a1 = cA + (size_t)(t + 1) * kstep;
            const char* a2 = last ? nA : cA + (size_t)(t + 2) * kstep; const char* b2 = last ? nB : cB + (size_t)(t + 2) * kstep;
            const char* a3 = a2 + kstep; const char* b3 = b2 + kstep;
            PG8_LDB(B0, 0, 0); PG8_LDB(B1, 0, 1); PG8_SCHED; PG8_LDA(At, 0, 0); PG8_STAGE(PG8_SA(1, 1), a1 + hstepA, voffA);
            PG8_WAIT_V(8); PG8_WAIT_L(0); PG8_BAR; PG8_MMA(0, 0, At, B0); PG8_MMA(0, 1, At, B1); PG8_BAR; PG8_SCHED;
            PG8_LDA(At, 0, 1); PG8_STAGE(PG8_SB(0, 0), b2, voffB); PG8_STAGE(PG8_SB(0, 1), b2 + hstepB, voffB); PG8_STAGE(PG8_SA(0, 0), a2, voffA);
            PG8_WAIT_V(8); PG8_WAIT_L(0); PG8_BAR; PG8_MMA(1, 0, At, B0); PG8_MMA(1, 1, At, B1); PG8_BAR; PG8_SCHED;
            PG8_LDB(B0, 1, 0); PG8_LDB(B1, 1, 1); PG8_SCHED; PG8_LDA(At, 1, 0); PG8_STAGE(PG8_SA(0, 1), a2 + hstepA, voffA);
            PG8_WAIT_V(8); PG8_WAIT_L(0); PG8_BAR; PG8_MMA(0, 0, At, B0); PG8_MMA(0, 1, At, B1); PG8_BAR; PG8_SCHED;
            PG8_LDA(At, 1, 1); PG8_STAGE(PG8_SB(1, 0), b3, voffB); PG8_STAGE(PG8_SB(1, 1), b3 + hstepB, voffB); PG8_STAGE(PG8_SA(1, 0), a3, voffA);
            PG8_WAIT_V(8); PG8_WAIT_L(0); PG8_BAR; PG8_MMA(1, 0, At, B0); PG8_MMA(1, 1, At, B1); PG8_BAR; PG8_SCHED;
        }
        if (wr == 0) PG8_BAR;
        E(acc, Epi::rowtile(cur.pm), cur.pn / g.ks, wr, wc, 0, 0, lds, ui & 1);
        if (!has_next) break;
        PG8_LANE_STATE();
#pragma unroll
        for (int a = 0; a < 2; ++a)
#pragma unroll
            for (int b = 0; b < 2; ++b)
#pragma unroll
                for (int m = 0; m < 4; ++m)
#pragma unroll
                    for (int n = 0; n < 2; ++n) acc[a][b][m][n] = (f32x4){0.f, 0.f, 0.f, 0.f};
        cur = nxt; cA = nA; cB = nB; ++ui;
        E.prefetch(lds, wid, Epi::rowtile(cur.pm), cur.pn / g.ks, ui & 1);
        if (wr == 1) PG8_BAR;
    }
    PG8_WAIT_V(0);
    PG8_BAR;
#undef PG8_SA
#undef PG8_SB
#undef PG8_STAGE
#undef PG8_LDA
#undef PG8_LDB
#undef PG8_MMA
#undef PG8_WAIT_V
#undef PG8_WAIT_L
#undef PG8_BAR
#undef PG8_SCHED
#undef PG8_LANE_STATE
#undef PG8_ABASE
#undef PG8_BBASE
}
}

typedef f32x4 AccT[2][2][4][2];
#define EPI_FENCE() do { asm volatile("" ::: "memory"); __builtin_amdgcn_sched_barrier(0); } while (0)

struct EpiIn {
    bf16_t* cq; float* sscq; bf16_t* u; bf16_t* gates;
    const float* g_kv; const float* g_kr; const f32x2* tab; float* out; bf16_t* lat; bf16_t* krb;
    static DI int rowtile(int pm) { return pm; }
    DI void prefetch(LAS unsigned char*, int, int, int, int) const {}
    DI void operator()(const AccT& acc, int pm, int pn, int wr, int wc, int fr, int fq, LAS unsigned char* lds, int slot) const {
        { const int l_ = fresh_lane(); fr = l_ & 15; fq = l_ >> 4; }
        const int row0 = pm * 256 + wr * 64 + fr, cl = wc * 32 + 4 * fq;
        if (pn == 0) {
#pragma unroll
            for (int ai = 0; ai < 2; ++ai)
#pragma unroll
                for (int m = 0; m < 4; ++m) { const size_t row = (size_t)(row0 + ai * 128 + m * 16); float ss = 0.f;
#pragma unroll
                    for (int bj = 0; bj < 2; ++bj)
#pragma unroll
                        for (int n = 0; n < 2; ++n) { const int c = cl + 128 * bj + 16 * n; const f32x4 v = acc[ai][bj][m][n];
                            u32x2 w; w.x = cvtpk(v[0], v[1]); w.y = cvtpk(v[2], v[3]); *(u32x2*)(cq + row * QL + c) = w;
                            ss += (v[0] * v[0] + v[1] * v[1]) + (v[2] * v[2] + v[3] * v[3]); }
                    ss = rowsum4(ss);
                    if (fq == 0) (void)__hip_atomic_fetch_add(sscq + row, ss, __ATOMIC_RELAXED, __HIP_MEMORY_SCOPE_AGENT); }
        } else if (pn == 1) {
            LAS float* X = (LAS float*)(lds + 131072 + 1024);
#pragma unroll
            for (int ai = 0; ai < 2; ++ai)
#pragma unroll
                for (int m = 0; m < 4; ++m) { const f32x4 a = acc[ai][0][m][0], b = acc[ai][0][m][1];
                    float ss = (a[0] * a[0] + a[1] * a[1]) + (a[2] * a[2] + a[3] * a[3]) + (b[0] * b[0] + b[1] * b[1]) + (b[2] * b[2] + b[3] * b[3]);
                    ss = rowsum4(ss);
                    if (fq == 0) X[(ai * 128 + wr * 64 + m * 16 + fr) * 4 + wc] = ss; }
            asm volatile("s_waitcnt lgkmcnt(0)" ::: "memory"); __builtin_amdgcn_s_barrier(); asm volatile("" ::: "memory");
            f32x4 gkv[2];
#pragma unroll
            for (int n = 0; n < 2; ++n) gkv[n] = *(const f32x4*)(g_kv + cl + 16 * n);
#pragma unroll
            for (int ai = 0; ai < 2; ++ai)
#pragma unroll
                for (int m = 0; m < 4; ++m) { const int rt = ai * 128 + wr * 64 + m * 16 + fr, rowi = pm * 256 + rt; const size_t row = (size_t)rowi;
                    const f32x4 ps = *(const LAS f32x4*)(X + rt * 4);
                    const float rkv = rsqrtf(((ps[0] + ps[1]) + (ps[2] + ps[3])) * (1.0f / KVL) + EPS);
                    const size_t lrow = (size_t)lat_row(rowi);
                    float* ol = rowi < MP ? out + O_PLAT + row * KVL : out + O_SLAT + (size_t)(rowi - MP) * KVL;
#pragma unroll
                    for (int n = 0; n < 2; ++n) { const int c = cl + 16 * n; const f32x4 lt = acc[ai][0][m][n] * gkv[n] * rkv;
                        *(f32x4*)(ol + c) = lt; u32x2 w; w.x = cvtpk(lt[0], lt[1]); w.y = cvtpk(lt[2], lt[3]); *(u32x2*)(lat + lrow * KVL + c) = w; }
                    if (wc == 0) {
                        const f32x4 a = acc[ai][1][m][0], b = acc[ai][1][m][1];
                        float ss = (a[0] * a[0] + a[1] * a[1]) + (a[2] * a[2] + a[3] * a[3]) + (b[0] * b[0] + b[1] * b[1]) + (b[2] * b[2] + b[3] * b[3]);
                        ss = rowsum4(ss);
                        const float rk = rsqrtf(ss * (1.0f / ROPE) + EPS);
                        const f32x4 g1 = *(const f32x4*)(g_kr + 4 * fq), g2 = *(const f32x4*)(g_kr + 16 + 4 * fq);
                        const f32x2* tp = tab + (size_t)row_pos(rowi) * 16 + 4 * fq;
                        const f32x4 cs01 = *(const f32x4*)tp, cs23 = *(const f32x4*)(tp + 2);
                        const float cc[4] = {cs01[0], cs01[2], cs23[0], cs23[2]}, sn[4] = {cs01[1], cs01[3], cs23[1], cs23[3]};
                        f32x4 o1, o2;
#pragma unroll
                        for (int i = 0; i < 4; ++i) { const float x1 = a[i] * g1[i] * rk, x2 = b[i] * g2[i] * rk; o1[i] = x1 * cc[i] - x2 * sn[i]; o2[i] = x1 * sn[i] + x2 * cc[i]; }
                        float* ok = rowi < MP ? out + O_PKR + row * ROPE : out + O_SKR + (size_t)(rowi - MP) * ROPE;
                        *(f32x4*)(ok + 4 * fq) = o1; *(f32x4*)(ok + 16 + 4 * fq) = o2;
                        u32x2 w; w.x = cvtpk(o1[0], o1[1]); w.y = cvtpk(o1[2], o1[3]); *(u32x2*)(krb + lrow * ROPE + 4 * fq) = w;
                        w.x = cvtpk(o2[0], o2[1]); w.y = cvtpk(o2[2], o2[3]); *(u32x2*)(krb + lrow * ROPE + 16 + 4 * fq) = w; }
                    EPI_FENCE(); }
        } else {
#pragma unroll
            for (int ai = 0; ai < 2; ++ai)
#pragma unroll
                for (int m = 0; m < 4; ++m) { const size_t row = (size_t)(row0 + ai * 128 + m * 16);
#pragma unroll
                    for (int bj = 0; bj < 2; ++bj) { const int c = wc * 32 + 8 * fq + 128 * bj; const f32x4 v = acc[ai][bj][m][0], v2 = acc[ai][bj][m][1];
                            u32x4 w;
                            if (pn < 6) { w.x = cvtpk(v[0], v[1]); w.y = cvtpk(v[2], v[3]); w.z = cvtpk(v2[0], v2[1]); w.w = cvtpk(v2[2], v2[3]); *(u32x4*)(u + row * DM + (pn - 2) * 256 + c) = w; }
                            else { w.x = cvtpk(SG2(v[0]), SG2(v[1])); w.y = cvtpk(SG2(v[2]), SG2(v[3])); w.z = cvtpk(SG2(v2[0]), SG2(v2[1])); w.w = cvtpk(SG2(v2[2]), SG2(v2[3]));
                                *(u32x4*)(gates + row * 2048 + (pn - 6) * 256 + c) = w; } } }
        }
    }
};

struct EpiLru {
    const bf16_t* uc; const float* b_rg; const float* b_ig; const float* sp8; bf16_t* la; bf16_t* bt;
    static DI int rowtile(int pm) { return pm; }
    DI void prefetch(LAS unsigned char*, int, int, int, int) const {}
    DI void operator()(const AccT& acc, int pm, int pn, int wr, int wc, int fr, int fq, LAS unsigned char* lds, int slot) const {
        { const int l_ = fresh_lane(); fr = l_ & 15; fq = l_ >> 4; }
        const int row0 = pm * 256 + wr * 64 + fr, ch = pn * 128 + wc * 32 + 8 * fq;
        float nbr[8], nbi[8], spa[8], spb[8];
#pragma unroll
        for (int h = 0; h < 2; ++h) { const f32x4 brg = *(const f32x4*)(b_rg + ch + 4 * h), big = *(const f32x4*)(b_ig + ch + 4 * h), sp = *(const f32x4*)(sp8 + ch + 4 * h);
#pragma unroll
            for (int i = 0; i < 4; ++i) { nbr[4 * h + i] = -LOG2E * brg[i]; nbi[4 * h + i] = -LOG2E * big[i]; spa[4 * h + i] = sp[i] * LOG2E; spb[4 * h + i] = sp[i] * (2.0f * LOG2E); } }
#pragma unroll
        for (int ai = 0; ai < 2; ++ai) {
            u32x4 uw[4];
#pragma unroll
            for (int m = 0; m < 4; ++m) uw[m] = *(const u32x4*)(uc + (size_t)(row0 + ai * 128 + m * 16) * DM + ch);
#pragma unroll
            for (int m = 0; m < 4; ++m) { const size_t row = (size_t)(row0 + ai * 128 + m * 16);
                const float uv[8] = {bflo(uw[m].x), bfhi(uw[m].x), bflo(uw[m].y), bfhi(uw[m].y), bflo(uw[m].z), bfhi(uw[m].z), bflo(uw[m].w), bfhi(uw[m].w)};
                float lo[8], bo[8];
#pragma unroll
                for (int n = 0; n < 2; ++n)
#pragma unroll
                    for (int i = 0; i < 4; ++i) { const int k = 4 * n + i;
                        const float r = __builtin_amdgcn_rcpf(1.0f + __builtin_amdgcn_exp2f(acc[ai][0][m][n][i] * -LOG2E + nbr[k]));
                        const float ig = __builtin_amdgcn_rcpf(1.0f + __builtin_amdgcn_exp2f(acc[ai][1][m][n][i] * -LOG2E + nbi[k]));
                        const float m2 = 1.0f - __builtin_amdgcn_exp2f(r * spb[k]);
                        lo[k] = r * spa[k]; bo[k] = __builtin_amdgcn_sqrtf(m2) * ig * uv[k]; }
                u32x4 w; w.x = cvtpk(lo[0], lo[1]); w.y = cvtpk(lo[2], lo[3]); w.z = cvtpk(lo[4], lo[5]); w.w = cvtpk(lo[6], lo[7]); *(u32x4*)(la + row * DM + ch) = w;
                w.x = cvtpk(bo[0], bo[1]); w.y = cvtpk(bo[2], bo[3]); w.z = cvtpk(bo[4], bo[5]); w.w = cvtpk(bo[6], bo[7]); *(u32x4*)(bt + row * DM + ch) = w; }
            EPI_FENCE(); }
    }
};

struct EpiQ {
    unsigned char* wsq; const float* g_qn; const float* g_qr; const f32x2* tab; const float* sscq;
    static DI int rowtile(int pm) { return pm; }
    DI void prefetch(LAS unsigned char*, int, int, int, int) const {}
    DI void operator()(const AccT& acc, int pm, int pn, int wr, int wc, int fr, int fq, LAS unsigned char* lds, int slot) const {
        { const int l_ = fresh_lane(); fr = l_ & 15; fq = l_ >> 4; }
        const int row0 = pm * 256 + wr * 64 + fr;
        bf16_t* q = q_part(wsq, (size_t)pm * 256);
        float rqv[2][4];
#pragma unroll
        for (int ai = 0; ai < 2; ++ai)
#pragma unroll
            for (int m = 0; m < 4; ++m) rqv[ai][m] = rsqrtf(sscq[row0 + ai * 128 + m * 16] * (1.0f / QL) + EPS);
        if (pn < 4) {
            const int head = 4 * pn + wc;
            f32x4 gq[2][2];
#pragma unroll
            for (int bj = 0; bj < 2; ++bj)
#pragma unroll
                for (int n = 0; n < 2; ++n) gq[bj][n] = *(const f32x4*)(g_qn + 32 * bj + 8 * fq + 4 * n);
#pragma unroll
            for (int ai = 0; ai < 2; ++ai)
#pragma unroll
                for (int m = 0; m < 4; ++m) { const size_t row = (size_t)(row0 + ai * 128 + m * 16);
                    float ss = 0.f;
#pragma unroll
                    for (int bj = 0; bj < 2; ++bj)
#pragma unroll
                        for (int n = 0; n < 2; ++n) { const f32x4 v = acc[ai][bj][m][n]; ss += (v[0] * v[0] + v[1] * v[1]) + (v[2] * v[2] + v[3] * v[3]); }
                    ss = rowsum4(ss);
                    const float rq = rqv[ai][m], r = rsqrtf(rq * rq * ss * (1.0f / 64.0f) + EPS) * rq * QSCALE;
#pragma unroll
                    for (int bj = 0; bj < 2; ++bj) { const f32x4 v0 = acc[ai][bj][m][0] * gq[bj][0] * r, v1 = acc[ai][bj][m][1] * gq[bj][1] * r;
                        u32x4 w; w.x = cvtpk(v0[0], v0[1]); w.y = cvtpk(v0[2], v0[3]); w.z = cvtpk(v1[0], v1[1]); w.w = cvtpk(v1[2], v1[3]);
                        *(u32x4*)(q + row * 1536 + head * QKD + 32 * bj + 8 * fq) = w; }
                    EPI_FENCE(); }
        } else {
            const f32x4 g1 = *(const f32x4*)(g_qr + 4 * fq), g2 = *(const f32x4*)(g_qr + 16 + 4 * fq);
#pragma unroll
            for (int ai = 0; ai < 2; ++ai) {
                f32x4 t01[4], t23[4];
#pragma unroll
                for (int m = 0; m < 4; ++m) { const f32x2* tp = tab + (size_t)row_pos(row0 + ai * 128 + m * 16) * 16 + 4 * fq; t01[m] = *(const f32x4*)tp; t23[m] = *(const f32x4*)(tp + 2); }
#pragma unroll
                for (int m = 0; m < 4; ++m) { const int rowi = row0 + ai * 128 + m * 16; const size_t row = (size_t)rowi;
                    const f32x4 cs01 = t01[m], cs23 = t23[m];
                    const float cc[4] = {cs01[0], cs01[2], cs23[0], cs23[2]}, sn[4] = {cs01[1], cs01[3], cs23[1], cs23[3]};
#pragma unroll
                    for (int bj = 0; bj < 2; ++bj) { const int head = 8 * (pn - 4) + 4 * bj + wc;
                        const f32x4 a = acc[ai][bj][m][0], b = acc[ai][bj][m][1];
                        float ss = (a[0] * a[0] + a[1] * a[1]) + (a[2] * a[2] + a[3] * a[3]) + (b[0] * b[0] + b[1] * b[1]) + (b[2] * b[2] + b[3] * b[3]);
                        ss = rowsum4(ss);
                        const float rq = rqv[ai][m], r = rsqrtf(rq * rq * ss * (1.0f / 32.0f) + EPS) * rq * QSCALE;
                        float o1[4], o2[4];
#pragma unroll
                        for (int i = 0; i < 4; ++i) { const float x1 = a[i] * g1[i] * r, x2 = b[i] * g2[i] * r; o1[i] = x1 * cc[i] - x2 * sn[i]; o2[i] = x1 * sn[i] + x2 * cc[i]; }
                        u32x2 w; w.x = cvtpk(o1[0], o1[1]); w.y = cvtpk(o1[2], o1[3]); *(u32x2*)(q + row * 1536 + head * QKD + 64 + 4 * fq) = w;
                        w.x = cvtpk(o2[0], o2[1]); w.y = cvtpk(o2[2], o2[3]); *(u32x2*)(q + row * 1536 + head * QKD + 80 + 4 * fq) = w; }
                    EPI_FENCE(); }
            }
        }
    }
};

struct EpiKV {
    bf16_t* kn; bf16_t* v; const float* g_kn;
    static DI int rowtile(int pm) { return pm; }
    DI void prefetch(LAS unsigned char*, int, int, int, int) const {}
    DI void operator()(const AccT& acc, int pm, int pn, int wr, int wc, int fr, int fq, LAS unsigned char* lds, int slot) const {
        { const int l_ = fresh_lane(); fr = l_ & 15; fq = l_ >> 4; }
        const int row0 = pm * 256 + wr * 64 + fr;
        const int head = 4 * (pn & 3) + wc;
        f32x4 gk[2][2];
#pragma unroll
        for (int bj = 0; bj < 2; ++bj)
#pragma unroll
            for (int n = 0; n < 2; ++n) gk[bj][n] = *(const f32x4*)(g_kn + 32 * bj + 8 * fq + 4 * n);
#pragma unroll
        for (int ai = 0; ai < 2; ++ai)
#pragma unroll
            for (int m = 0; m < 4; ++m) { const size_t row = (size_t)(row0 + ai * 128 + m * 16);
                if (pn < 4) {
                    float ss = 0.f;
#pragma unroll
                    for (int bj = 0; bj < 2; ++bj)
#pragma unroll
                        for (int n = 0; n < 2; ++n) { const f32x4 x = acc[ai][bj][m][n]; ss += (x[0] * x[0] + x[1] * x[1]) + (x[2] * x[2] + x[3] * x[3]); }
                    ss = rowsum4(ss);
                    const float r = rsqrtf(ss * (1.0f / 64.0f) + EPS);
#pragma unroll
                    for (int bj = 0; bj < 2; ++bj) { const f32x4 v0 = acc[ai][bj][m][0] * gk[bj][0] * r, v1 = acc[ai][bj][m][1] * gk[bj][1] * r;
                        u32x4 w; w.x = cvtpk(v0[0], v0[1]); w.y = cvtpk(v0[2], v0[3]); w.z = cvtpk(v1[0], v1[1]); w.w = cvtpk(v1[2], v1[3]);
                        *(u32x4*)(kn + row * 1024 + head * 64 + 32 * bj + 8 * fq) = w; }
                } else {
#pragma unroll
                    for (int bj = 0; bj < 2; ++bj) { const f32x4 v0 = acc[ai][bj][m][0], v1 = acc[ai][bj][m][1];
                        u32x4 w; w.x = cvtpk(v0[0], v0[1]); w.y = cvtpk(v0[2], v0[3]); w.z = cvtpk(v1[0], v1[1]); w.w = cvtpk(v1[2], v1[3]);
                        *(u32x4*)(v + row * 1024 + head * 64 + 32 * bj + 8 * fq) = w; }
                }
                EPI_FENCE(); }
    }
};

struct EpiOut {
    const float* xp; bf16_t* xmb; float* ssrow;
    static DI int rowtile(int pm) { return pm; }
    DI void prefetch(LAS unsigned char*, int, int, int, int) const {}
    DI void operator()(const AccT& acc, int pm, int pn, int wr, int wc, int fr, int fq, LAS unsigned char* lds, int slot) const {
        { const int l_ = fresh_lane(); fr = l_ & 15; fq = l_ >> 4; }
        const int row0 = pm * 256 + wr * 64 + fr, cl = pn * 256 + wc * 32 + 8 * fq;
#pragma unroll
        for (int ai = 0; ai < 2; ++ai)
#pragma unroll
            for (int m = 0; m < 4; ++m) { const size_t row = (size_t)(row0 + ai * 128 + m * 16);
                const float* xr = xp + row * DM;
                float ss = 0.f;
#pragma unroll
                for (int bj = 0; bj < 2; ++bj) { const int c = cl + 128 * bj; const f32x4 v = *(const f32x4*)(xr + c) + acc[ai][bj][m][0], v2 = *(const f32x4*)(xr + c + 4) + acc[ai][bj][m][1];
                        u32x4 w; w.x = cvtpk(v[0], v[1]); w.y = cvtpk(v[2], v[3]); w.z = cvtpk(v2[0], v2[1]); w.w = cvtpk(v2[2], v2[3]); *(u32x4*)(xmb + (row + 2) * DM + c) = w;
                        ss += ((v[0] * v[0] + v[1] * v[1]) + (v[2] * v[2] + v[3] * v[3])) + ((v2[0] * v2[0] + v2[1] * v2[1]) + (v2[2] * v2[2] + v2[3] * v2[3])); }
                ss = rowsum4(ss);
                if (fq == 0) (void)__hip_atomic_fetch_add(ssrow + row + 2, ss, __ATOMIC_RELAXED, __HIP_MEMORY_SCOPE_AGENT); }
    }
};

constexpr int UP_SLOT0 = 131072 + 1024, UP_SLOT_BYTES = 5120;
template <bool FAST>
struct EpiUp {
    const float* ssrow; const float* cws; const float* st; bf16_t* hff; float* o_pffn; float* o_sffn;
    static constexpr int N_FAST = 62, N_SLOW = 7;
    static DI int rowtile(int pm) {
        if (FAST) { int r = pm + 1; if (r >= 16) ++r; if (r >= 33) ++r; if (r >= 49) ++r; return r; }
        return pm == 0 ? 0 : pm == 1 ? 16 : pm == 2 ? 33 : pm == 3 ? 49 : 62 + pm;
    }
    DI void prefetch(LAS unsigned char* lds, int wid, int pm, int pn, int slot) const {
        const int lane = fresh_lane();
        LAS unsigned char* sb = lds + UP_SLOT0 + slot * UP_SLOT_BYTES;
        const float* src = cws + (wid & 3) * NUP + (wid >> 2) * DFF + pn * 128 + lane;
        __builtin_amdgcn_global_load_lds((const unsigned*)src, (LAS unsigned*)(sb + wid * 512), 4, 0, 0);
        __builtin_amdgcn_global_load_lds((const unsigned*)(src + 64), (LAS unsigned*)(sb + wid * 512 + 256), 4, 0, 0);
        if (wid < 4) __builtin_amdgcn_global_load_lds((const unsigned*)(ssrow + (pm * 248 + 62 * wid + lane)), (LAS unsigned*)(sb + 4096 + wid * 256), 4, 0, 0);
    }
    DI void operator()(const AccT& acc, int pm, int pn, int wr, int wc, int fr, int fq, LAS unsigned char* lds, int slot) const {
        const LAS float* P = (const LAS float*)(lds + UP_SLOT0 + slot * UP_SLOT_BYTES);
        if constexpr (FAST) {
#pragma unroll
            for (int ai = 0; ai < 2; ++ai) {
                { const int l_ = fresh_lane(); fr = l_ & 15; fq = l_ >> 4; }
                const int seg = 2 * ai + wr, e0 = pm * 248 + 62 * seg - 2 + 4 * fr;
                const f32x4 ss4 = *(const LAS f32x4*)(P + 1024 + seg * 64 + 4 * fr);
                float r2[4];
#pragma unroll
                for (int m = 0; m < 4; ++m) r2[m] = rsqrtf(ss4[m] * (1.0f / DM) + EPS);
                u32x2 hpa[4];
#pragma unroll
                for (int n = 0; n < 2; ++n) { const int cc = wc * 32 + 8 * fq + 4 * n, ch = pn * 128 + cc;
                    f32x4 prm[8];
#pragma unroll
                    for (int k = 0; k < 8; ++k) prm[k] = *(const LAS f32x4*)(P + k * 128 + cc);
                    unsigned hp0[4];
#pragma unroll
                    for (int ip = 0; ip < 2; ++ip) {
                        float hres[4][2];
#pragma unroll
                        for (int ii = 0; ii < 2; ++ii) { const int i = 2 * ip + ii;
                            const float wg0 = prm[0][i], wg1 = prm[1][i], wg2 = prm[2][i], bg = prm[3][i], wv0 = prm[4][i], wv1 = prm[5][i], wv2 = prm[6][i], bv = prm[7][i];
                            float xg[4], xv[4];
#pragma unroll
                            for (int m = 0; m < 4; ++m) { xg[m] = acc[ai][0][m][n][i] * r2[m]; xv[m] = acc[ai][1][m][n][i] * r2[m]; }
                            float cg[4], cv[4];
                            cg[0] = wg2 * xg[0] + bg;                               cv[0] = wv2 * xv[0] + bv;
                            cg[1] = wg2 * xg[1] + (wg1 * xg[0] + bg);               cv[1] = wv2 * xv[1] + (wv1 * xv[0] + bv);
                            cg[2] = wg2 * xg[2] + (wg1 * xg[1] + (wg0 * xg[0] + bg)); cv[2] = wv2 * xv[2] + (wv1 * xv[1] + (wv0 * xv[0] + bv));
                            cg[3] = wg2 * xg[3] + (wg1 * xg[2] + (wg0 * xg[1] + bg)); cv[3] = wv2 * xv[3] + (wv1 * xv[2] + (wv0 * xv[1] + bv));
                            asm("s_nop 1\n\t"
                                "v_fmac_f32_dpp %0, %4, %6 row_ror:1 row_mask:0xf bank_mask:0xf\n\tv_fmac_f32_dpp %0, %5, %7 row_ror:1 row_mask:0xf bank_mask:0xf\n\tv_fmac_f32_dpp %1, %4, %7 row_ror:1 row_mask:0xf bank_mask:0xf\n\t"
                                "v_fmac_f32_dpp %2, %8, %10 row_ror:1 row_mask:0xf bank_mask:0xf\n\tv_fmac_f32_dpp %2, %9, %11 row_ror:1 row_mask:0xf bank_mask:0xf\n\tv_fmac_f32_dpp %3, %8, %11 row_ror:1 row_mask:0xf bank_mask:0xf"
                                : "+v"(cg[0]), "+v"(cg[1]), "+v"(cv[0]), "+v"(cv[1])
                                : "v"(xg[3]), "v"(xg[2]), "v"(wg1), "v"(wg0), "v"(xv[3]), "v"(xv[2]), "v"(wv1), "v"(wv0));
#pragma unroll
                            for (int m = 0; m < 4; ++m) hres[m][ii] = cg[m] * cv[m] * __builtin_amdgcn_rcpf(1.0f + __builtin_amdgcn_exp2f(cg[m]));
                        }
#pragma unroll
                        for (int m = 0; m < 4; ++m) { const unsigned pk = cvtpk(hres[m][0], hres[m][1]);
                            if (ip == 0) hp0[m] = pk;
                            else if (n == 0) { hpa[m].x = hp0[m]; hpa[m].y = pk; }
                            else if (m >= 2 || fr > 0) { u32x4 w; w.x = hpa[m].x; w.y = hpa[m].y; w.z = hp0[m]; w.w = pk; *(u32x4*)(hff + (size_t)(e0 + m) * DFF + ch - 4) = w; } }
                    }
                    EPI_FENCE();
                }
            }
            return;
        }
#pragma unroll
        for (int ai = 0; ai < 2; ++ai) {
            { const int l_ = fresh_lane(); fr = l_ & 15; fq = l_ >> 4; }
            const int e0 = pm * 248 + 62 * (2 * ai + wr) - 2 + fr;
            float r2[4];
#pragma unroll
            for (int m = 0; m < 4; ++m) r2[m] = rsqrtf(P[1024 + (2 * ai + wr) * 64 + 16 * m + fr] * (1.0f / DM) + EPS);
            unsigned long long bnd[4];
#pragma unroll
            for (int m = 0; m < 4; ++m) { const int j = 16 * m + fr, e = e0 + 16 * m; bool nd = false;
                if (j >= 2 && e < MT) { const int t = e < MP ? (e & (PT - 1)) : ((e - MP) & (ST - 1)); const int T = e < MP ? PT : ST; nd = (t < 2) || (t >= T - 2); }
                bnd[m] = __builtin_amdgcn_ballot_w64(nd); }
#pragma unroll
            for (int n = 0; n < 2; ++n) { const int cc = wc * 32 + 8 * fq + 4 * n, ch = pn * 128 + cc;
                f32x4 prm[8];
#pragma unroll
                for (int k = 0; k < 8; ++k) prm[k] = *(const LAS f32x4*)(P + k * 128 + cc);
                unsigned hp0[4];
#pragma unroll
                for (int ip = 0; ip < 2; ++ip) {
                    float hres[4][2];
#pragma unroll
                    for (int ii = 0; ii < 2; ++ii) { const int i = 2 * ip + ii;
                        const float wg0 = prm[0][i], wg1 = prm[1][i], wg2 = prm[2][i], bg = prm[3][i], wv0 = prm[4][i], wv1 = prm[5][i], wv2 = prm[6][i], bv = prm[7][i];
                        float pg = 0.f, pv = 0.f;
#pragma unroll
                        for (int m = 0; m < 4; ++m) {
                            const float xg = acc[ai][0][m][n][i] * r2[m], xv = acc[ai][1][m][n][i] * r2[m];
                            if (FAST) {
                                const float sg1 = fr == 15 ? pg : xg, sg2 = fr >= 14 ? pg : xg, sv1 = fr == 15 ? pv : xv, sv2 = fr >= 14 ? pv : xv;
                                float cg = wg2 * xg + bg, cv = wv2 * xv + bv;
                                asm("s_nop 1\n\tv_fmac_f32_dpp %0, %2, %4 row_ror:1 row_mask:0xf bank_mask:0xf\n\tv_fmac_f32_dpp %0, %3, %5 row_ror:2 row_mask:0xf bank_mask:0xf\n\t"
                                    "v_fmac_f32_dpp %1, %6, %8 row_ror:1 row_mask:0xf bank_mask:0xf\n\tv_fmac_f32_dpp %1, %7, %9 row_ror:2 row_mask:0xf bank_mask:0xf"
                                    : "+v"(cg), "+v"(cv) : "v"(sg1), "v"(sg2), "v"(wg1), "v"(wg0), "v"(sv1), "v"(sv2), "v"(wv1), "v"(wv0));
                                pg = xg; pv = xv;
                                hres[m][ii] = cg * cv * __builtin_amdgcn_rcpf(1.0f + __builtin_amdgcn_exp2f(cg));
                                continue;
                            }
                            float g1 = dpp_mov<0x121>(fr == 15 ? pg : xg), g2 = dpp_mov<0x122>(fr >= 14 ? pg : xg);
                            float v1 = dpp_mov<0x121>(fr == 15 ? pv : xv), v2 = dpp_mov<0x122>(fr >= 14 ? pv : xv);
                            pg = xg; pv = xv;
                            if (!FAST && bnd[m] != 0ull) {
                                const int j = 16 * m + fr, e = e0 + 16 * m;
                                if (j >= 2 && e < MT) {
                                    const int t = e < MP ? (e & (PT - 1)) : ((e - MP) & (ST - 1));
                                    const int T = e < MP ? PT : ST;
                                    if (t < 2) {
                                        float s0g = 0.f, s1g = 0.f, s0v = 0.f, s1v = 0.f;
                                        if (e >= MP) { const float* sb = st + (size_t)((e - MP) >> 5) * 2 * NUP + ch + i; s0g = sb[0]; s1g = sb[NUP]; s0v = sb[DFF]; s1v = sb[NUP + DFF]; }
                                        if (t == 0) { g1 = s1g; g2 = s0g; v1 = s1v; v2 = s0v; } else { g2 = s1g; v2 = s1v; }
                                    }
                                    if (t >= T - 2) {
                                        float* ob = (e < MP ? o_pffn + ((size_t)(e >> 12) * 2 + (t - (T - 2))) * NUP : o_sffn + ((size_t)((e - MP) >> 5) * 2 + (t - (T - 2))) * NUP) + ch + i;
                                        ob[0] = xg; ob[DFF] = xv; }
                                }
                            }
                            const float cg = wg0 * g2 + wg1 * g1 + wg2 * xg + bg, cv = wv0 * v2 + wv1 * v1 + wv2 * xv + bv;
                            hres[m][ii] = cg * cv * __builtin_amdgcn_rcpf(1.0f + __builtin_amdgcn_exp2f(cg));
                        }
                    }
#pragma unroll
                    for (int m = 0; m < 4; ++m) { const int j = 16 * m + fr, e = e0 + 16 * m; const unsigned pk = cvtpk(hres[m][0], hres[m][1]);
                        if (ip == 0) hp0[m] = pk; else if (j >= 2 && (FAST || e < MT)) { u32x2 w; w.x = hp0[m]; w.y = pk; *(u32x2*)(hff + (size_t)e * DFF + ch) = w; } }
                    if (!FAST) EPI_FENCE();
                }
                EPI_FENCE();
            }
        }
    }
};
namespace pg8 { template <> struct RowPerm<EpiUp<true>> { static constexpr bool v = true; }; }

struct EpiDown {
    const bf16_t* xmb; float* y;
    static DI int rowtile(int pm) { return pm; }
    DI void prefetch(LAS unsigned char*, int, int, int, int) const {}
    DI void operator()(const AccT& acc, int pm, int pn, int wr, int wc, int fr, int fq, LAS unsigned char* lds, int slot) const {
        { const int l_ = fresh_lane(); fr = l_ & 15; fq = l_ >> 4; }
        const int row0 = pm * 256 + wr * 64 + fr, cl = pn * 256 + wc * 32 + 4 * fq;
#pragma unroll
        for (int ai = 0; ai < 2; ++ai)
#pragma unroll
            for (int m = 0; m < 4; ++m) { const size_t row = (size_t)(row0 + ai * 128 + m * 16); float* yr = y + row * DM; const bf16_t* xr = xmb + (row + 2) * DM;
#pragma unroll
                for (int bj = 0; bj < 2; ++bj)
#pragma unroll
                    for (int n = 0; n < 2; ++n) { const int c = cl + 128 * bj + 16 * n; const u32x2 w = *(const u32x2*)(xr + c);
                        *(f32x4*)(yr + c) = (f32x4){bflo(w.x), bfhi(w.x), bflo(w.y), bfhi(w.y)} + acc[ai][bj][m][n]; } }
    }
};

constexpr int NWAVES = 8, NTHREADS = 512;
constexpr int RING_BYTES = 131072, LDS_BYTES = 147456;
constexpr int N_PHASES = 8;

struct Args { const float* in[30]; float* out; unsigned char* ws; int ph_lo, ph_hi; };

struct Frame {
    LAS unsigned char* lds; int wave, G, bid; unsigned char* ws; float* out;
    DI const float* in(int i) const { const LAS unsigned* p = (const LAS unsigned*)(lds + RING_BYTES) + 2 * i; const unsigned lo_ = __builtin_amdgcn_readfirstlane(p[0]), hi_ = __builtin_amdgcn_readfirstlane(p[1]);
        return (const float*)(((unsigned long long)hi_ << 32) | lo_); }
};

DI void tr_item(const float* W, int ldw, const float* fold, bf16_t* WT, int K, int k0, int nrow0, int sc, LAS float* scr, int lane, float cs = 1.0f) {
    f32x4 v[8];
#pragma unroll
    for (int i = 0; i < 8; ++i) { const int kk = (lane >> 3) + 8 * i; v[i] = (f32x4){0.f, 0.f, 0.f, 0.f};
        if (sc >= 0) { v[i] = *(const f32x4*)(W + (size_t)(k0 + kk) * ldw + sc) * cs; if (fold) v[i] = v[i] * fold[k0 + kk]; } }
#pragma unroll
    for (int i = 0; i < 8; ++i) { const int kk = (lane >> 3) + 8 * i; LAS float* d = scr + kk * 33 + 4 * (lane & 7); d[0] = v[i][0]; d[1] = v[i][1]; d[2] = v[i][2]; d[3] = v[i][3]; }
    LDS_WAIT();
    const int c = lane & 7;
#pragma unroll
    for (int j = 0; j < 4; ++j) { const int n = (lane >> 3) + 8 * j; const LAS float* s = scr + (8 * c) * 33 + n;
        u32x4 o; o.x = cvtpk(s[0 * 33], s[1 * 33]); o.y = cvtpk(s[2 * 33], s[3 * 33]); o.z = cvtpk(s[4 * 33], s[5 * 33]); o.w = cvtpk(s[6 * 33], s[7 * 33]);
        *(u32x4*)(WT + (size_t)(nrow0 + n) * K + k0 + 8 * c) = o; }
    LDS_WAIT();
}
DI int dperm(int cc, int bj) { return 32 * bj + 8 * ((cc >> 2) & 3) + 4 * ((cc >> 4) & 1) + (cc & 3); }
DI int src_win(int n) { if (n < 416) return n; if (n < 512) return -1; const int s_ = n - 512; return 416 + (s_ & ~31) + dperm(s_ & 31, 0); }
DI int src_wqb(int n) { const int pn = n >> 8, c = n & 255, bj = c >> 7, wc = (c >> 5) & 3, cc = c & 31;
    if (pn < 4) return (4 * pn + wc) * QKD + dperm(cc, bj);
    return (8 * (pn - 4) + 4 * bj + wc) * QKD + 64 + cc; }
DI int src_wkvb(int n) { const int pn = n >> 8, c = n & 255, bj = c >> 7, wc = (c >> 5) & 3, cc = c & 31;
    if (pn < 4) return (4 * pn + wc) * 128 + dperm(cc, bj);
    return (4 * (pn - 4) + wc) * 128 + 64 + dperm(cc, bj); }
DI int src_wup(int n) { const int pn = n >> 8, c = n & 255; return (c >> 7) * DFF + 128 * pn + (c & 96) + dperm(c & 31, 0); }

struct TrDesc { const float* W; const float* fold; bf16_t* WT; int ldw, K, k0, nrow0, sc; };
DI TrDesc late_desc(Frame& F, int r, int lane) {
    constexpr int I_OUT = 16 * 32, I_UP = 16 * 176;
    unsigned char* ws = F.ws;
    if (r < I_OUT) { const int kb = r / 32, nb = r % 32; return TrDesc{F.in(24), nullptr, (bf16_t*)(ws + WS_WOUT), 1024, 1024, 64 * kb, 32 * nb, 32 * nb + dperm(4 * (lane & 7), 0)}; }
    r -= I_OUT;
    if (r < I_UP) { const int kb = r / 176, nb = r % 176; return TrDesc{F.in(26), F.in(25), (bf16_t*)(ws + WS_WUP), NUP, 1024, 64 * kb, 32 * nb, src_wup(32 * nb + 4 * (lane & 7))}; }
    r -= I_UP;
    { const int kb = r / 32, nb = r % 32; return TrDesc{F.in(29), nullptr, (bf16_t*)(ws + WS_WDOWN), 1024, DFF, 64 * kb, 32 * nb, 32 * nb + 4 * (lane & 7)}; }
}
DI void tr_issue(const TrDesc& d, f32x4 (&v)[8], float (&fv)[8], int lane) {
#pragma unroll
    for (int i = 0; i < 8; ++i) { const int kk = (lane >> 3) + 8 * i; v[i] = *(const f32x4*)(d.W + (size_t)(d.k0 + kk) * d.ldw + d.sc); fv[i] = d.fold ? d.fold[d.k0 + kk] : 1.0f; }
}
DI void tr_finish(const TrDesc& d, const f32x4 (&v)[8], const float (&fv)[8], LAS float* scr, int lane) {
#pragma unroll
    for (int i = 0; i < 8; ++i) { const int kk = (lane >> 3) + 8 * i; LAS float* dd = scr + kk * 33 + 4 * (lane & 7); const f32x4 x = v[i] * fv[i]; dd[0] = x[0]; dd[1] = x[1]; dd[2] = x[2]; dd[3] = x[3]; }
    LDS_WAIT();
    const int c = lane & 7;
#pragma unroll
    for (int j = 0; j < 4; ++j) { const int n = (lane >> 3) + 8 * j; const LAS float* sp = scr + (8 * c) * 33 + n;
        u32x4 o; o.x = cvtpk(sp[0 * 33], sp[1 * 33]); o.y = cvtpk(sp[2 * 33], sp[3 * 33]); o.z = cvtpk(sp[4 * 33], sp[5 * 33]); o.w = cvtpk(sp[6 * 33], sp[7 * 33]);
        *(u32x4*)(d.WT + (size_t)(d.nrow0 + n) * d.K + d.k0 + 8 * c) = o; }
    LDS_WAIT();
}
constexpr int LATE_ITEMS = 16 * 32 + 16 * 176 + 44 * 32, LATE_DOWN0 = 16 * 32 + 16 * 176;
DI void late_weights(Frame& F, int worker, int nworkers, int it_lo, int NIT) {
    LAS float* scr = (LAS float*)(F.lds + F.wave * 16384);
    const int lane = fresh_lane();
    int r0 = it_lo + worker; if (r0 >= NIT) return;
    TrDesc dc = late_desc(F, r0, lane); f32x4 vc[8]; float fc[8];
    tr_issue(dc, vc, fc, lane);
    for (;;) {
        const int rn = r0 + nworkers; const bool more = rn < NIT;
        TrDesc dn = dc; f32x4 vn[8]; float fn[8];
        if (more) { dn = late_desc(F, rn, lane); tr_issue(dn, vn, fn, lane); }
        tr_finish(dc, vc, fc, scr, lane);
        if (!more) break;
        dc = dn; r0 = rn;
#pragma unroll
        for (int i = 0; i < 8; ++i) { vc[i] = vn[i]; fc[i] = fn[i]; }
    }
}

constexpr int CACHE_P0 = 2;
constexpr int CACHE_LATE = 8;
DI void cache_convert(Frame& F, int gt, int NGT, int s_lo, int s_hi) {
    unsigned char* ws = F.ws;
    { const float* cl = F.in(2); const float* ck = F.in(3);
      const int l_lo = s_lo * PAST * (KVL / 8), l_hi = s_hi * PAST * (KVL / 8);
      for (int i0 = l_lo + gt; i0 < l_hi; i0 += 4 * NGT) {
        f32x4 a[4], bq[4];
#pragma unroll
        for (int q = 0; q < 4; ++q) { int i = i0 + q * NGT; i = i < l_hi ? i : l_hi - 1; const float* sp = cl + (size_t)(i >> 4) * KVL + (i & 15) * 8; a[q] = *(const f32x4*)sp; bq[q] = *(const f32x4*)(sp + 4); }
#pragma unroll
        for (int q = 0; q < 4; ++q) { const int i = i0 + q * NGT; if (i >= l_hi) break; const int row = i >> 4, c8 = (i & 15) * 8, b = row >> 12, j = row & 4095;
            u32x4 w; w.x = cvtpk(a[q][0], a[q][1]); w.y = cvtpk(a[q][2], a[q][3]); w.z = cvtpk(bq[q][0], bq[q][1]); w.w = cvtpk(bq[q][2], bq[q][3]);
            *(u32x4*)((bf16_t*)(ws + WS_LAT) + (size_t)(MP + b * SKEYS + j) * KVL + c8) = w; } }
      const int r_lo = s_lo * PAST * (ROPE / 8), r_hi = s_hi * PAST * (ROPE / 8);
      for (int i = r_lo + gt; i < r_hi; i += NGT) { const int row = i >> 2, c8 = (i & 3) * 8, b = row >> 12, j = row & 4095;
        const float* sp = ck + (size_t)row * ROPE + c8; const f32x4 a = *(const f32x4*)sp, bq = *(const f32x4*)(sp + 4);
        u32x4 w; w.x = cvtpk(a[0], a[1]); w.y = cvtpk(a[2], a[3]); w.z = cvtpk(bq[0], bq[1]); w.w = cvtpk(bq[2], bq[3]);
        *(u32x4*)((bf16_t*)(ws + WS_KR) + (size_t)(MP + b * SKEYS + j) * ROPE + c8) = w; } }
}

DI void p0_prologue(Frame& F) {
    LAS float* scr = (LAS float*)(F.lds + F.wave * 16384);
    const int lane = fresh_lane(), tid = F.wave * 64 + lane;
    const int gw = F.bid * NWAVES + F.wave, NGW = F.G * NWAVES;
    unsigned char* ws = F.ws;
    constexpr int I_IN = 16 * 112, I_QB = 4 * 48, I_KVB = 2 * 64, I_KVN = 2 * 64, I_LRU = 16 * 8;
    constexpr int NITEMS = I_IN + I_QB + I_KVB + I_KVN + I_LRU;
    for (int k = 0; k * NGW < NITEMS; ++k) {
        int it = gw + k * NGW;
        if (NGW == 2048 && k == 1) it = 2 * NGW - 1 - gw;
        if (it >= NITEMS) continue;
        int r = it;
        if (r < I_IN) { const int kb = r / 112, nb = r % 112; tr_item(F.in(8), 3488, nullptr, (bf16_t*)(ws + WS_WIN), 1024, 64 * kb, 32 * nb, src_win(32 * nb + 4 * (lane & 7)), scr, lane, nb >= 48 ? -LOG2E : 1.0f); continue; } r -= I_IN;
        if (r < I_QB) { const int kb = r / 48, nb = r % 48; tr_item(F.in(10), 1536, F.in(9), (bf16_t*)(ws + WS_WQB), 256, 64 * kb, 32 * nb, src_wqb(32 * nb + 4 * (lane & 7)), scr, lane); continue; } r -= I_QB;
        if (r < I_KVB) { const int kb = r / 64, nb = r % 64; tr_item(F.in(12), 2048, nullptr, (bf16_t*)(ws + WS_WKVB), 128, 64 * kb, 32 * nb, src_wkvb(32 * nb + 4 * (lane & 7)), scr, lane); continue; } r -= I_KVB;
        if (r < I_KVN) { const int kb = r / 64, nb = r % 64; tr_item(F.in(12), 2048, nullptr, (bf16_t*)(ws + WS_WKVN), 128, 64 * kb, 32 * nb, 32 * nb + 4 * (lane & 7), scr, lane); continue; } r -= I_KVN;
        { const int mat = r >> 3, sub = r & 7, blk = mat >> 1, bj = mat & 1, kb = sub >> 2, nb = sub & 3;
            tr_item((bj ? F.in(21) : F.in(19)) + (size_t)blk * 16384, 128, nullptr, (bf16_t*)(ws + WS_WLRU), 128, 64 * kb, blk * 256 + bj * 128 + 32 * nb, 32 * nb + dperm(4 * (lane & 7), 0), scr, lane); }
    }
    const float* gm = F.in(7);
    { const float* x0 = F.in(0); const float* x1 = F.in(1);
      for (int m0 = 2 * gw; m0 < MT; m0 += 2 * NGW) {
        f32x4 v[2][4]; float s[2];
#pragma unroll
        for (int q = 0; q < 2; ++q) { const int m = m0 + q; const float* xr = m < MP ? x0 + (size_t)m * DM : x1 + (size_t)(m - MP) * DM; s[q] = 0.f;
#pragma unroll
            for (int j = 0; j < 4; ++j) { v[q][j] = *(const f32x4*)(xr + 4 * lane + 256 * j); s[q] += (v[q][j][0] * v[q][j][0] + v[q][j][1] * v[q][j][1]) + (v[q][j][2] * v[q][j][2] + v[q][j][3] * v[q][j][3]); } }
#pragma unroll
        for (int q = 0; q < 2; ++q) { const float r = rsqrtf(wave_sum(s[q]) * (1.0f / DM) + EPS);
            bf16_t* o = (bf16_t*)(ws + WS_XN) + (size_t)(m0 + q) * DM;
#pragma unroll
            for (int j = 0; j < 4; ++j) { const f32x4 g = *(const f32x4*)(gm + 4 * lane + 256 * j); const f32x4 y = v[q][j] * g * r;
                u32x2 w; w.x = cvtpk(y[0], y[1]); w.y = cvtpk(y[2], y[3]); *(u32x2*)(o + 4 * lane + 256 * j) = w; } }
      } }
    const int gt = F.bid * NTHREADS + tid, NGT = F.G * NTHREADS;
    cache_convert(F, gt, NGT, 0, F.G == 256 ? CACHE_P0 : SB);
    for (int i = gt; i < MT; i += NGT) ((float*)(ws + WS_SSCQ))[i] = 0.f;
    for (int i = gt; i < XMB_ROWS + 2; i += NGT) ((float*)(ws + WS_SSROW))[i] = 0.f;
    for (int i = gt; i < 4 * NUP; i += NGT) { const int row = i / NUP, c = i - row * NUP;
        ((float*)(ws + WS_CWS))[i] = (row < 3 ? F.in(27)[i] : F.in(28)[c]) * (c < DFF ? -1.4426950408889634f : -0.6931471805599453f); }
    for (int i = gt; i < DM; i += NGT) { const float x = -F.in(23)[i]; ((float*)(ws + WS_SP8))[i] = -8.0f * (x > 15.f ? x : log1pf(__expf(x))); }
    for (int i = gt; i < SKEYS * 16; i += NGT) { const int pos = i >> 4, k = i & 15;
        const float inv = exp2f(-(float)k * (13.287712379549449f / 16.0f));
        const double rev = (double)((float)pos * inv) * 0.15915494309189535;
        const float fr_ = (float)(rev - floor(rev));
        ((f32x2*)(ws + WS_TAB))[i] = (f32x2){__builtin_amdgcn_cosf(fr_), __builtin_amdgcn_sinf(fr_)}; }
}

template <int GR>
DI void conv_rows(Frame& F, const int m0, const int c, const bf16_t* u, const float* cw, const float* cb, const float* cst) {
    const int t0 = m0 < MP ? (m0 & (PT - 1)) : ((m0 - MP) & (ST - 1)); const int T = m0 < MP ? PT : ST;
    u32x4 ux[GR + 3];
#pragma unroll
    for (int i = 0; i < GR + 3; ++i) { const int row = (t0 == 0 && i < 3) ? m0 : m0 - 3 + i;
        ux[i] = *(const u32x4*)(u + (size_t)row * DM + c); }
    float x[GR + 3][8];
#pragma unroll
    for (int i = 0; i < GR + 3; ++i) { const u32x4 w = ux[i];
        x[i][0] = bflo(w.x); x[i][1] = bfhi(w.x); x[i][2] = bflo(w.y); x[i][3] = bfhi(w.y); x[i][4] = bflo(w.z); x[i][5] = bfhi(w.z); x[i][6] = bflo(w.w); x[i][7] = bfhi(w.w); }
    if (t0 == 0) {
#pragma unroll
        for (int i = 0; i < 3; ++i) {
            if (m0 >= MP) { const float* sp = cst + ((size_t)((m0 - MP) >> 5) * 3 + i) * DM + c; const f32x4 a = *(const f32x4*)sp, b = *(const f32x4*)(sp + 4);
                x[i][0] = a[0]; x[i][1] = a[1]; x[i][2] = a[2]; x[i][3] = a[3]; x[i][4] = b[0]; x[i][5] = b[1]; x[i][6] = b[2]; x[i][7] = b[3]; }
            else {
#pragma unroll
                for (int e = 0; e < 8; ++e) x[i][e] = 0.f; } } }
    f32x4 w0[4], w1[4];
#pragma unroll
    for (int j = 0; j < 4; ++j) { w0[j] = *(const f32x4*)(cw + j * DM + c); w1[j] = *(const f32x4*)(cw + j * DM + c + 4); }
    const f32x4 b0 = *(const f32x4*)(cb + c), b1 = *(const f32x4*)(cb + c + 4);
    bf16_t* ucp = (bf16_t*)(F.ws + WS_UC);
#pragma unroll
    for (int r = 0; r < GR; ++r) { const int m = m0 + r, t = t0 + r;
        float y[8];
#pragma unroll
        for (int e = 0; e < 4; ++e) { y[e] = b0[e]; y[4 + e] = b1[e]; }
#pragma unroll
        for (int j = 0; j < 4; ++j)
#pragma unroll
            for (int e = 0; e < 4; ++e) { y[e] += w0[j][e] * x[r + j][e]; y[4 + e] += w1[j][e] * x[r + j][4 + e]; }
        u32x4 w; w.x = cvtpk(y[0], y[1]); w.y = cvtpk(y[2], y[3]); w.z = cvtpk(y[4], y[5]); w.w = cvtpk(y[6], y[7]);
        *(u32x4*)(ucp + (size_t)m * DM + c) = w;
        if (t >= T - 3) { float* oc = m < MP ? F.out + O_PCONV + ((size_t)(m >> 12) * 3 + (t - (T - 3))) * DM : F.out + O_SCONV + ((size_t)((m - MP) >> 5) * 3 + (t - (T - 3))) * DM;
            *(f32x4*)(oc + c) = (f32x4){x[r + 3][0], x[r + 3][1], x[r + 3][2], x[r + 3][3]}; *(f32x4*)(oc + c + 4) = (f32x4){x[r + 3][4], x[r + 3][5], x[r + 3][6], x[r + 3][7]}; } }
}
DI void conv_own_units(Frame& F, const pg8::StaticOrder& S) {
    const int tid = F.wave * 64 + fresh_lane();
    const bf16_t* u = (const bf16_t*)(F.out + O_Y); const float* cw = F.in(17); const float* cb = F.in(18); const float* cst = F.in(5);
    pg8::Unit un;
    for (int i = 0; S.next(i, un); ++i) conv_rows<8>(F, un.pm * 256 + (tid >> 4) * 8, un.pn * 128 + (tid & 15) * 8, u, cw, cb, cst);
    asm volatile("s_waitcnt vmcnt(0)" ::: "memory"); __syncthreads();
}

DI void lru_small(Frame& F) {
    const int lane = fresh_lane(), wid = F.wave, l15 = lane & 15, kq = lane >> 4;
    const bf16_t* uc = (const bf16_t*)(F.ws + WS_UC); const bf16_t* wl = (const bf16_t*)(F.ws + WS_WLRU);
    bf16_t* la = (bf16_t*)(F.ws + WS_LA); bf16_t* bt = (bf16_t*)(F.ws + WS_BT);
    const float* b_rg = F.in(20); const float* b_ig = F.in(22); const float* sp8 = (const float*)(F.ws + WS_SP8);
    for (int task = F.bid; task < (MS / 16) * 8; task += F.G) {
        const int rbk = task >> 3, blk = task & 7;
        if (wid == 0) conv_rows<4>(F, MP + rbk * 16 + (lane >> 4) * 4, blk * 128 + (lane & 15) * 8, (const bf16_t*)(F.out + O_Y), F.in(17), F.in(18), F.in(5));
        asm volatile("s_waitcnt vmcnt(0)" ::: "memory"); __syncthreads();
        const bf16_t* ap = uc + (size_t)(MP + rbk * 16 + l15) * DM + blk * 128 + 8 * kq;
        const bf16_t* bp = wl + (size_t)(blk * 256 + 16 * wid + l15) * 128 + 8 * kq;
        bf16x8 a[4], br[4], bi[4];
#pragma unroll
        for (int s = 0; s < 4; ++s) { a[s] = *(const bf16x8*)(ap + 32 * s); br[s] = *(const bf16x8*)(bp + 32 * s); bi[s] = *(const bf16x8*)(bp + (size_t)128 * 128 + 32 * s); }
        f32x4 cr = (f32x4){0.f, 0.f, 0.f, 0.f}, ci = cr;
#pragma unroll
        for (int s = 0; s < 4; ++s) { cr = __builtin_amdgcn_mfma_f32_16x16x32_bf16(a[s], br[s], cr, 0, 0, 0); ci = __builtin_amdgcn_mfma_f32_16x16x32_bf16(a[s], bi[s], ci, 0, 0, 0); }
        const int ch = blk * 128 + ((16 * wid + l15) & ~31) + dperm((16 * wid + l15) & 31, 0);
        const float brg = b_rg[ch], big = b_ig[ch], sp = sp8[ch];
#pragma unroll
        for (int r = 0; r < 4; ++r) { const size_t row = (size_t)MP + rbk * 16 + 4 * kq + r;
            const float uv = bf2f(uc[row * DM + ch]);
            const float rg = sigmoidf_(cr[r] + brg), ig = sigmoidf_(ci[r] + big);
            const float loga = rg * sp, m2 = 1.0f - __builtin_amdgcn_exp2f(2.0f * loga * LOG2E);
            la[row * DM + ch] = (bf16_t)(cvtpk(loga * LOG2E, 0.f) & 0xffffu);
            bt[row * DM + ch] = (bf16_t)(cvtpk(sqrtf(m2) * ig * uv, 0.f) & 0xffffu); }
    }
}

DI void scan_local_own(Frame& F, const pg8::StaticOrder& S) {
    const bf16_t* la = (const bf16_t*)(F.ws + WS_LA); const bf16_t* bt = (const bf16_t*)(F.ws + WS_BT);
    float* Ap = (float*)(F.ws + WS_AGG); float* Bp = Ap + PB * 64 * DM;
    const int tid = F.wave * 64 + fresh_lane();
    asm volatile("s_waitcnt vmcnt(0)" ::: "memory"); __syncthreads();
    pg8::Unit u;
    for (int i = 0; S.next(i, u); i += 2) {
        pg8::Unit v = u; const int which = tid >> 8; bool have = true;
        if (which == 1) have = S.next(i + 1, v);
        if (have) { const int seg4 = (tid >> 6) & 3, cp = v.pn * 64 + (tid & 63);
            const int row0 = v.pm * 256 + seg4 * 64, b = row0 >> 12, seg = (row0 & (PT - 1)) >> 6; const size_t base = (size_t)row0 * DM + 2 * cp;
            float A0 = 1.f, A1 = 1.f, H0 = 0.f, H1 = 0.f;
#pragma unroll 8
            for (int t = 0; t < 64; ++t) { const unsigned lw = *(const unsigned*)(la + base + (size_t)t * DM), bw = *(const unsigned*)(bt + base + (size_t)t * DM);
                const float a0 = __builtin_amdgcn_exp2f(bflo(lw)), a1 = __builtin_amdgcn_exp2f(bfhi(lw)); H0 = a0 * H0 + bflo(bw); H1 = a1 * H1 + bfhi(bw); A0 *= a0; A1 *= a1; }
            *(f32x2*)(Ap + ((size_t)b * 64 + seg) * DM + 2 * cp) = (f32x2){A0, A1}; *(f32x2*)(Bp + ((size_t)b * 64 + seg) * DM + 2 * cp) = (f32x2){H0, H1}; }
    }
}
constexpr int SCAN_EXTRA0 = (MT / 256) * 6 - 256;
DI void p5_scan_apply(Frame& F) {
    const bf16_t* la = (const bf16_t*)(F.ws + WS_LA); const bf16_t* bt = (const bf16_t*)(F.ws + WS_BT); bf16_t* gates = (bf16_t*)(F.ws + WS_GATES);
    const float* Ap = (const float*)(F.ws + WS_AGG); const float* Bp = Ap + PB * 64 * DM;
    const int NP = PB * 64 * 512, NS = SB * 512;
    const int tid = F.wave * 64 + fresh_lane();
    for (int it = 0;; ++it) {
        int idx;
        if (F.G == 256) { if (it == 0) idx = (F.bid >> 6) * 32768 + (((F.bid & 63) + 8 * F.wave) & 63) * 512 + tid;
            else if (it == 1 && F.bid >= SCAN_EXTRA0 && F.bid < SCAN_EXTRA0 + NS / NTHREADS) idx = NP + (F.bid - SCAN_EXTRA0) * NTHREADS + tid; else break; }
        else { idx = F.bid * NTHREADS + tid + it * F.G * NTHREADS; if (idx >= NP + NS) break; }
        float H0, H1; size_t row0; int nsteps; float* oh = nullptr; int cp;
        if (idx < NP) { cp = idx & 511; const int seg = (idx >> 9) & 63, b = idx >> 15; H0 = 0.f; H1 = 0.f;
            for (int s0 = 0; s0 < seg; s0 += 8) {
                f32x2 a[8], h[8];
#pragma unroll
                for (int q = 0; q < 8; ++q) { const int si = s0 + q < 63 ? s0 + q : 63; a[q] = *(const f32x2*)(Ap + ((size_t)b * 64 + si) * DM + 2 * cp); h[q] = *(const f32x2*)(Bp + ((size_t)b * 64 + si) * DM + 2 * cp); }
#pragma unroll
                for (int q = 0; q < 8; ++q) if (s0 + q < seg) { H0 = a[q][0] * H0 + h[q][0]; H1 = a[q][1] * H1 + h[q][1]; } }
            row0 = (size_t)b * PT + seg * 64; nsteps = 64; if (seg == 63) oh = F.out + O_PH + (size_t)b * DM + 2 * cp; }
        else { const int j = idx - NP; cp = j & 511; const int b = j >> 9; const f32x2 h = *(const f32x2*)(F.in(4) + (size_t)b * DM + 2 * cp); H0 = h[0]; H1 = h[1];
            row0 = (size_t)MP + b * ST; nsteps = ST; oh = F.out + O_SH + (size_t)b * DM + 2 * cp; }
        for (int t0 = 0; t0 < nsteps; t0 += 8) {
            unsigned lw[8], bw[8], gv[8];
#pragma unroll
            for (int t = 0; t < 8; ++t) { const size_t r = row0 + t0 + t; lw[t] = *(const unsigned*)(la + r * DM + 2 * cp); bw[t] = *(const unsigned*)(bt + r * DM + 2 * cp); gv[t] = *(const unsigned*)(gates + r * 2048 + 1024 + 2 * cp); }
#pragma unroll
            for (int t = 0; t < 8; ++t) { H0 = __builtin_amdgcn_exp2f(bflo(lw[t])) * H0 + bflo(bw[t]); H1 = __builtin_amdgcn_exp2f(bfhi(lw[t])) * H1 + bfhi(bw[t]); gv[t] = cvtpk(bflo(gv[t]) * H0, bfhi(gv[t]) * H1); }
#pragma unroll
            for (int t = 0; t < 8; ++t) *(unsigned*)(gates + (row0 + t0 + t) * 2048 + 1024 + 2 * cp) = gv[t];
        }
        if (oh) *(f32x2*)oh = (f32x2){H0, H1};
    }
}

struct FinOut {
    const float* xs; bf16_t* xmb; float* ssrow;
    DI void operator()(int row, int cb, int col, f32x4 sum, int lane) const {
        col = (col & ~31) + dperm(col & 31, 0);
        const size_t m = (size_t)MP + row; const f32x4 v = *(const f32x4*)(xs + (size_t)row * DM + col) + sum;
        u32x2 w; w.x = cvtpk(v[0], v[1]); w.y = cvtpk(v[2], v[3]); *(u32x2*)(xmb + (m + 2) * DM + col) = w;
        float ss = (v[0] * v[0] + v[1] * v[1]) + (v[2] * v[2] + v[3] * v[3]);
        ss += __shfl_xor(ss, 1); ss += __shfl_xor(ss, 2); ss += __shfl_xor(ss, 4); ss += __shfl_xor(ss, 8);
        if ((lane & 15) == 0) (void)__hip_atomic_fetch_add(ssrow + m + 2, ss, __ATOMIC_RELAXED, __HIP_MEMORY_SCOPE_AGENT); }
};
struct FinDown {
    const bf16_t* xmb; float* y;
    DI void operator()(int row, int cb, int col, f32x4 sum, int lane) const { const size_t m = (size_t)MP + row; const u32x2 w = *(const u32x2*)(xmb + (m + 2) * DM + col);
        *(f32x4*)(y + m * DM + col) = (f32x4){bflo(w.x), bfhi(w.x), bflo(w.y), bfhi(w.y)} + sum; }
};
template <int STEPS, class Fin>
DI void small_gemm(Frame& F, const bf16_t* A, int lda, const bf16_t* Bt, int ldb, const Fin& fin) {
    LAS char* lds = (LAS char*)F.lds;
    const int lane = fresh_lane(), wid = F.wave, tid = wid * 64 + lane, l15 = lane & 15, kq = lane >> 4;
    constexpr int NK = STEPS / 2;
    static_assert(STEPS % 2 == 0, "small_gemm k-steps of 32");
    LAS char* sb = lds + wid * 12288;
    const unsigned frd = (unsigned)l15 * 64u + (unsigned)kq * 16u;
#define SG_VMWAIT(n) asm volatile("s_waitcnt vmcnt(" #n ")" ::: "memory")
    for (int u = F.bid; u < (MS / 32) * 16; u += F.G) {
        const int rb = u >> 4, cb = u & 15;
        const bf16_t* ga = A + (size_t)(rb * 32 + (lane >> 2)) * lda + wid * STEPS * 16 + 8 * (lane & 3);
        const bf16_t* gb = Bt + (size_t)(cb * 64 + (lane >> 2)) * ldb + wid * STEPS * 16 + 8 * (lane & 3);
#define SG_ISSUE(ks_, bf_) do { \
        _Pragma("unroll") for (int j_ = 0; j_ < 2; ++j_) __builtin_amdgcn_global_load_lds((const unsigned*)(ga + (size_t)(16 * j_) * lda + (ks_) * 32), (LAS unsigned*)(sb + (bf_) * 6144 + j_ * 1024), 16, 0, 0); \
        _Pragma("unroll") for (int j_ = 0; j_ < 4; ++j_) __builtin_amdgcn_global_load_lds((const unsigned*)(gb + (size_t)(16 * j_) * ldb + (ks_) * 32), (LAS unsigned*)(sb + (bf_) * 6144 + (2 + j_) * 1024), 16, 0, 0); } while (0)
        f32x4 acc[2][4];
#pragma unroll
        for (int i = 0; i < 2; ++i)
#pragma unroll
            for (int j = 0; j < 4; ++j) acc[i][j] = (f32x4){0.f, 0.f, 0.f, 0.f};
        SG_ISSUE(0, 0); if (NK > 1) SG_ISSUE(1, 1);
#pragma unroll
        for (int ks = 0; ks < NK; ++ks) {
            if (ks + 1 < NK) SG_VMWAIT(6); else SG_VMWAIT(0);
            bf16x8 a[2], b[4];
#pragma unroll
            for (int i = 0; i < 2; ++i) a[i] = *(const LAS bf16x8*)(sb + (ks & 1) * 6144 + i * 1024 + frd);
#pragma unroll
            for (int j = 0; j < 4; ++j) b[j] = *(const LAS bf16x8*)(sb + (ks & 1) * 6144 + (2 + j) * 1024 + frd);
            asm volatile("s_waitcnt lgkmcnt(0)" ::: "memory");
            if (ks + 2 < NK) SG_ISSUE(ks + 2, ks & 1);
#pragma unroll
            for (int i = 0; i < 2; ++i)
#pragma unroll
                for (int j = 0; j < 4; ++j) acc[i][j] = __builtin_amdgcn_mfma_f32_16x16x32_bf16(a[i], b[j], acc[i][j], 0, 0, 0);
        }
#undef SG_ISSUE
        __syncthreads();
        LAS float* ob = (LAS float*)lds + wid * 2048;
#pragma unroll
        for (int i = 0; i < 2; ++i)
#pragma unroll
            for (int j = 0; j < 4; ++j)
#pragma unroll
                for (int r = 0; r < 4; ++r) ob[(16 * i + 4 * kq + r) * 64 + 16 * j + l15] = acc[i][j][r];
        __syncthreads();
        { const int row = tid >> 4, c4 = (tid & 15) * 4; f32x4 sum = (f32x4){0.f, 0.f, 0.f, 0.f};
#pragma unroll
          for (int w = 0; w < 8; ++w) sum += *(const LAS f32x4*)((const LAS float*)lds + w * 2048 + row * 64 + c4);
          fin(rb * 32 + row, cb, cb * 64 + c4, sum, lane); }
        __syncthreads();
    }
#undef SG_VMWAIT
}

DI s16x4 vtr(const LAS char* p) { return __builtin_bit_cast(s16x4, __builtin_amdgcn_ds_read_tr16_b64_v4i16((LAS s16x4*)p)); }
constexpr int KCH = 1024;

DI float attn_negb(Frame& F) {
    float mqn = 0.f, mqr = 0.f, mkn = 0.f, mkr = 0.f;
    for (int i = 0; i < 64; ++i) { mqn = fmaxf(mqn, fabsf(F.in(13)[i])); mkn = fmaxf(mkn, fabsf(F.in(15)[i])); }
    for (int i = 0; i < 32; ++i) { mqr = fmaxf(mqr, fabsf(F.in(14)[i])); mkr = fmaxf(mkr, fabsf(F.in(16)[i])); }
    const float bq = sqrtf(64.f * mqn * mqn + 32.f * mqr * mqr), bk = sqrtf(64.f * mkn * mkn + 32.f * mkr * mkr);
    return -(bq * bk * QSCALE * 1.001f);
}

DI void merge_store8(const bf16_t* gates, bf16_t* mix, size_t m, int col, const float* o) {
    const u32x4 ga = *(const u32x4*)(gates + m * 2048 + col), rr = *(const u32x4*)(gates + m * 2048 + 1024 + col);
    u32x4 w;
    w.x = cvtpk(bflo(ga.x) * o[0] + bflo(rr.x), bfhi(ga.x) * o[1] + bfhi(rr.x)); w.y = cvtpk(bflo(ga.y) * o[2] + bflo(rr.y), bfhi(ga.y) * o[3] + bfhi(rr.y));
    w.z = cvtpk(bflo(ga.z) * o[4] + bflo(rr.z), bfhi(ga.z) * o[5] + bfhi(rr.z)); w.w = cvtpk(bflo(ga.w) * o[6] + bflo(rr.w), bfhi(ga.w) * o[7] + bfhi(rr.w));
    *(u32x4*)(mix + m * DM + col) = w;
}

constexpr int A_SLOT = 12288 + 8192, A_NS = 4;
constexpr int A_WSF = A_NS * A_SLOT, A_OST = A_WSF + 2048, A_END = A_OST + 8 * 4096;
static_assert(A_END <= 131072, "attention LDS");
#define VMWAIT(n) asm volatile("s_waitcnt vmcnt(" #n ")" ::: "memory")
DI void attn_prompt_unit(Frame& F, int b, int h, int qb, float negb) {
    LAS char* lds = (LAS char*)F.lds;
    const int lane = fresh_lane(), wid = F.wave, r32 = lane & 31, hi = lane >> 5;
    const bf16_t* KN = (const bf16_t*)(F.out + O_Y); const bf16_t* V = KN + (size_t)MP * DM;
    const bf16_t* KR = (const bf16_t*)(F.ws + WS_KR);
    const size_t rowbase = (size_t)b * PT; const int q0 = qb * 256;
    const bf16_t* Q = q_part(F.ws, rowbase + q0);
    const int NT = (q0 + 256) / 64, cw = (q0 + 32 * wid) / 64;
    const bf16_t* kng = KN + (rowbase + lane) * DM + h * 64 + wid * 8;
    const bf16_t* krg = KR + (rowbase + lane) * ROPE + (wid & 3) * 8;
    const bf16_t* vg = V + (rowbase + 16 * (wid & 3) + (lane >> 2)) * DM + h * 64 + (wid >> 2) * 32 + (lane & 3) * 8;
#define A_DMA(t) do { const int sl_ = ((t) & 3) * A_SLOT; const size_t adv_ = (size_t)(t) * 64; \
        __builtin_amdgcn_global_load_lds((const unsigned*)(kng + adv_ * DM), (LAS unsigned*)(lds + sl_ + wid * KCH), 16, 0, 0); \
        if (wid < 4) __builtin_amdgcn_global_load_lds((const unsigned*)(krg + adv_ * ROPE), (LAS unsigned*)(lds + sl_ + (8 + wid) * KCH), 16, 0, 0); \
        __builtin_amdgcn_global_load_lds((const unsigned*)(vg + adv_ * DM), (LAS unsigned*)(lds + sl_ + 12288 + wid * 1024), 16, 0, 0); } while (0)
    A_DMA(0); if (NT > 1) A_DMA(1); if (NT > 2) A_DMA(2);
    bf16x8 qf[6];
    { const bf16_t* qp = Q + (rowbase + q0 + wid * 32 + r32) * 1536 + h * QKD + 8 * hi;
#pragma unroll
      for (int s = 0; s < 6; ++s) qf[s] = *(const bf16x8*)(qp + 16 * s); }
    f32x16 o0, o1, negm;
#pragma unroll
    for (int r = 0; r < 16; ++r) { o0[r] = 0.f; o1[r] = 0.f; negm[r] = negb; }
    float lsum = 0.f;
    const int vrd = ((lane >> 4) & 1) * 32 + (lane & 3) * 8 + (4 * hi + ((lane & 15) >> 2)) * 64;
    for (int t = 0; t < NT; ++t) {
        { const int rem = NT - 1 - t;
          if (rem >= 2) { if (wid < 4) VMWAIT(6); else VMWAIT(4); }
          else if (rem == 1) { if (wid < 4) VMWAIT(3); else VMWAIT(2); }
          else VMWAIT(0); }
        __builtin_amdgcn_s_barrier(); asm volatile("" ::: "memory");
        if (t + 3 < NT) A_DMA(t + 3);
        if (t <= cw) {
            const LAS char* kb = lds + (t & 3) * A_SLOT + r32 * 16;
            f32x16 p0 = negm, p1 = negm;
#pragma unroll
            for (int s = 0; s < 6; ++s) { const bf16x8 a0 = *(const LAS bf16x8*)(kb + (2 * s + hi) * KCH), a1 = *(const LAS bf16x8*)(kb + (2 * s + hi) * KCH + 512);
                p0 = MFMA32(a0, qf[s], p0); p1 = MFMA32(a1, qf[s], p1); }
            float sacc = 0.f;
#pragma unroll
            for (int r = 0; r < 16; ++r) { p0[r] = __builtin_amdgcn_exp2f(p0[r]); p1[r] = __builtin_amdgcn_exp2f(p1[r]); sacc += p0[r] + p1[r]; }
            lsum += sacc;
            u32x4 pw[4];
#pragma unroll
            for (int e = 0; e < 4; ++e) { pw[0][e] = cvtpk(p0[2 * e], p0[2 * e + 1]); pw[1][e] = cvtpk(p0[8 + 2 * e], p0[8 + 2 * e + 1]); pw[2][e] = cvtpk(p1[2 * e], p1[2 * e + 1]); pw[3][e] = cvtpk(p1[8 + 2 * e], p1[8 + 2 * e + 1]); }
            const LAS char* vb = lds + (t & 3) * A_SLOT + 12288 + vrd;
#pragma unroll
            for (int s2 = 0; s2 < 4; ++s2) {
                const s16x4 l0 = vtr(vb + s2 * 1024), h0 = vtr(vb + s2 * 1024 + 512), l1 = vtr(vb + 4096 + s2 * 1024), h1 = vtr(vb + 4096 + s2 * 1024 + 512);
                const bf16x8 vf0 = __builtin_shufflevector(l0, h0, 0, 1, 2, 3, 4, 5, 6, 7), vf1 = __builtin_shufflevector(l1, h1, 0, 1, 2, 3, 4, 5, 6, 7);
                const bf16x8 pa = __builtin_bit_cast(bf16x8, pw[s2]);
                o0 = MFMA32(pa, vf0, o0); o1 = MFMA32(pa, vf1, o1); }
        }
    }
#undef A_DMA
    lsum += __shfl_xor(lsum, 32);
    LAS float* wsf = (LAS float*)(lds + A_WSF) + wid * 64;
    if (hi == 0) wsf[r32] = lsum;
    LDS_WAIT();
    LAS bf16_t* stg = (LAS bf16_t*)(lds + A_OST) + wid * 2048;
#pragma unroll
    for (int r = 0; r < 16; ++r) { const int orow = crow(r, hi); const float rl = __builtin_amdgcn_rcpf(wsf[orow]);
        stg[orow * 64 + r32] = (bf16_t)(cvtpk(o0[r] * rl, 0.f) & 0xffffu); stg[orow * 64 + 32 + r32] = (bf16_t)(cvtpk(o1[r] * rl, 0.f) & 0xffffu); }
    LDS_WAIT();
    const bf16_t* gates = (const bf16_t*)(F.ws + WS_GATES); bf16_t* mix = (bf16_t*)(F.ws + WS_MIX);
#pragma unroll
    for (int i = 0; i < 4; ++i) { const int row = i * 8 + (lane >> 3), ch = lane & 7; const u32x4 v = *(const LAS u32x4*)(stg + row * 64 + ch * 8);
        const float o[8] = {bflo(v.x), bfhi(v.x), bflo(v.y), bfhi(v.y), bflo(v.z), bfhi(v.z), bflo(v.w), bfhi(v.w)};
        merge_store8(gates, mix, rowbase + q0 + wid * 32 + row, h * 64 + ch * 8, o); }
    __syncthreads();
}

DI void attn_prompt_unit64(Frame& F, int b, int h, int qb2) {
    LAS char* lds = (LAS char*)F.lds;
    const int lane = fresh_lane(), wid = F.wave, r32 = lane & 31, hi = lane >> 5;
    const bf16_t* KN = (const bf16_t*)(F.out + O_Y); const bf16_t* V = KN + (size_t)MP * DM;
    const bf16_t* KR = (const bf16_t*)(F.ws + WS_KR);
    const size_t rowbase = (size_t)b * PT; const int q0 = qb2 * 512;
    const bf16_t* Q = q_part(F.ws, rowbase + q0);
    const int NT = (q0 + 512) / 64, cw = q0 / 64 + wid;
    const bf16_t* kng = KN + (rowbase + lane) * DM + h * 64 + wid * 8;
    const bf16_t* krg = KR + (rowbase + lane) * ROPE + (wid & 3) * 8;
    const bf16_t* vg = V + (rowbase + 16 * (wid & 3) + (lane >> 2)) * DM + h * 64 + (wid >> 2) * 32 + (lane & 3) * 8;
#define A_DMA(t) do { const int sl_ = ((t) & 3) * A_SLOT; const size_t adv_ = (size_t)(t) * 64; \
        __builtin_amdgcn_global_load_lds((const unsigned*)(kng + adv_ * DM), (LAS unsigned*)(lds + sl_ + wid * KCH), 16, 0, 0); \
        if (wid < 4) __builtin_amdgcn_global_load_lds((const unsigned*)(krg + adv_ * ROPE), (LAS unsigned*)(lds + sl_ + (8 + wid) * KCH), 16, 0, 0); \
        __builtin_amdgcn_global_load_lds((const unsigned*)(vg + adv_ * DM), (LAS unsigned*)(lds + sl_ + 12288 + wid * 1024), 16, 0, 0); } while (0)
    A_DMA(0); A_DMA(1); A_DMA(2);
    bf16x8 qf[2][6];
#pragma unroll
    for (int hf = 0; hf < 2; ++hf) { const bf16_t* qp = Q + (rowbase + q0 + wid * 64 + hf * 32 + r32) * 1536 + h * QKD + 8 * hi;
#pragma unroll
        for (int s = 0; s < 6; ++s) qf[hf][s] = *(const bf16x8*)(qp + 16 * s); }
    const f32x16 zero16 = (f32x16){0.f, 0.f, 0.f, 0.f, 0.f, 0.f, 0.f, 0.f, 0.f, 0.f, 0.f, 0.f, 0.f, 0.f, 0.f, 0.f};
    f32x16 o[2][2];
#pragma unroll
    for (int hf = 0; hf < 2; ++hf) { o[hf][0] = zero16; o[hf][1] = zero16; }
    float lsum[2] = {0.f, 0.f};
    const int vrd = ((lane >> 4) & 1) * 32 + (lane & 3) * 8 + (4 * hi + ((lane & 15) >> 2)) * 64;
    for (int t = 0; t < NT; ++t) {
        { const int rem = NT - 1 - t;
          if (rem >= 2) { if (wid < 4) VMWAIT(6); else VMWAIT(4); }
          else if (rem == 1) { if (wid < 4) VMWAIT(3); else VMWAIT(2); }
          else VMWAIT(0); }
        __builtin_amdgcn_s_barrier(); asm volatile("" ::: "memory");
        if (t + 3 < NT) A_DMA(t + 3);
        if (t <= cw) {
            const LAS char* kb = lds + (t & 3) * A_SLOT + r32 * 16;
            f32x16 p[2][2];
#pragma unroll
            for (int s = 0; s < 6; ++s) { const bf16x8 a0 = *(const LAS bf16x8*)(kb + (2 * s + hi) * KCH), a1 = *(const LAS bf16x8*)(kb + (2 * s + hi) * KCH + 512);
#pragma unroll
                for (int hf = 0; hf < 2; ++hf) { p[hf][0] = MFMA32(a0, qf[hf][s], s == 0 ? zero16 : p[hf][0]); p[hf][1] = MFMA32(a1, qf[hf][s], s == 0 ? zero16 : p[hf][1]); } }
            u32x4 pw[2][4];
#pragma unroll
            for (int hf = 0; hf < 2; ++hf) { float sacc = 0.f;
#pragma unroll
                for (int r = 0; r < 16; ++r) { p[hf][0][r] = __builtin_amdgcn_exp2f(p[hf][0][r]); p[hf][1][r] = __builtin_amdgcn_exp2f(p[hf][1][r]); sacc += p[hf][0][r] + p[hf][1][r]; }
                lsum[hf] += sacc;
#pragma unroll
                for (int e = 0; e < 4; ++e) { pw[hf][0][e] = cvtpk(p[hf][0][2 * e], p[hf][0][2 * e + 1]); pw[hf][1][e] = cvtpk(p[hf][0][8 + 2 * e], p[hf][0][8 + 2 * e + 1]);
                    pw[hf][2][e] = cvtpk(p[hf][1][2 * e], p[hf][1][2 * e + 1]); pw[hf][3][e] = cvtpk(p[hf][1][8 + 2 * e], p[hf][1][8 + 2 * e + 1]); } }
            const LAS char* vb = lds + (t & 3) * A_SLOT + 12288 + vrd;
#pragma unroll
            for (int s2 = 0; s2 < 4; ++s2) {
                const s16x4 l0 = vtr(vb + s2 * 1024), h0 = vtr(vb + s2 * 1024 + 512), l1 = vtr(vb + 4096 + s2 * 1024), h1 = vtr(vb + 4096 + s2 * 1024 + 512);
                const bf16x8 vf0 = __builtin_shufflevector(l0, h0, 0, 1, 2, 3, 4, 5, 6, 7), vf1 = __builtin_shufflevector(l1, h1, 0, 1, 2, 3, 4, 5, 6, 7);
#pragma unroll
                for (int hf = 0; hf < 2; ++hf) { const bf16x8 pa = __builtin_bit_cast(bf16x8, pw[hf][s2]); o[hf][0] = MFMA32(pa, vf0, o[hf][0]); o[hf][1] = MFMA32(pa, vf1, o[hf][1]); } }
        }
    }
#undef A_DMA
    const bf16_t* gates = (const bf16_t*)(F.ws + WS_GATES); bf16_t* mix = (bf16_t*)(F.ws + WS_MIX);
    LAS float* wsf = (LAS float*)(lds + A_WSF) + wid * 64;
    LAS bf16_t* stg = (LAS bf16_t*)(lds + A_OST) + wid * 2048;
#pragma unroll
    for (int hf = 0; hf < 2; ++hf) {
        float l = lsum[hf]; l += __shfl_xor(l, 32);
        if (hi == 0) wsf[r32] = l;
        LDS_WAIT();
#pragma unroll
        for (int r = 0; r < 16; ++r) { const int orow = crow(r, hi); const float rl = __builtin_amdgcn_rcpf(wsf[orow]);
            stg[orow * 64 + r32] = (bf16_t)(cvtpk(o[hf][0][r] * rl, 0.f) & 0xffffu); stg[orow * 64 + 32 + r32] = (bf16_t)(cvtpk(o[hf][1][r] * rl, 0.f) & 0xffffu); }
        LDS_WAIT();
#pragma unroll
        for (int i = 0; i < 4; ++i) { const int row = i * 8 + (lane >> 3), ch = lane & 7; const u32x4 v = *(const LAS u32x4*)(stg + row * 64 + ch * 8);
            const float ov[8] = {bflo(v.x), bfhi(v.x), bflo(v.y), bfhi(v.y), bflo(v.z), bfhi(v.z), bflo(v.w), bfhi(v.w)};
            merge_store8(gates, mix, rowbase + q0 + wid * 64 + hf * 32 + row, h * 64 + ch * 8, ov); }
        LDS_WAIT();
    }
    __syncthreads();
}

constexpr int S_WLD = 272;
constexpr int S_W0 = 0, S_OBUF = 128 * S_WLD  , S_LBUF = S_OBUF + 8 * 8192, S_END = S_LBUF + 8 * 128;
DI void attn_sample_unit(Frame& F, int b, int h, float negb) {
    LAS char* lds = (LAS char*)F.lds;
    const int lane = fresh_lane(), wid = F.wave, tid = wid * 64 + lane, r32 = lane & 31, hi = lane >> 5;
    const bf16_t* Q = q_part(F.ws, (size_t)MP); const bf16_t* LAT = (const bf16_t*)(F.ws + WS_LAT); const bf16_t* KR = (const bf16_t*)(F.ws + WS_KR);
    const bf16_t* WN = (const bf16_t*)(F.ws + WS_WKVN) + (size_t)h * 128 * 128;
    for (int i = tid; i < 128 * 16; i += NTHREADS) { const int r = i >> 4, c = i & 15; *(LAS u32x4*)(lds + S_W0 + r * S_WLD + c * 16) = *(const u32x4*)(WN + r * 128 + c * 8); }
    const bf16_t* qp = Q + ((size_t)MP + b * ST + r32) * 1536 + h * QKD;
    const float* gkn = F.in(15);
    bf16x8 qn[4], qr[2];
#pragma unroll
    for (int s = 0; s < 4; ++s) { const u32x2 a = *(const u32x2*)(qp + 16 * s + 4 * hi), c = *(const u32x2*)(qp + 16 * s + 8 + 4 * hi);
        const f32x4 ga = *(const f32x4*)(gkn + 16 * s + 4 * hi), gc = *(const f32x4*)(gkn + 16 * s + 8 + 4 * hi);
        u32x4 w; w.x = cvtpk(bflo(a.x) * ga[0], bfhi(a.x) * ga[1]); w.y = cvtpk(bflo(a.y) * ga[2], bfhi(a.y) * ga[3]); w.z = cvtpk(bflo(c.x) * gc[0], bfhi(c.x) * gc[1]); w.w = cvtpk(bflo(c.y) * gc[2], bfhi(c.y) * gc[3]);
        qn[s] = __builtin_bit_cast(bf16x8, w); }
#pragma unroll
    for (int s = 0; s < 2; ++s) qr[s] = *(const bf16x8*)(qp + 64 + 16 * s + 8 * hi);
    f32x16 o0, o1;
#pragma unroll
    for (int r = 0; r < 16; ++r) { o0[r] = 0.f; o1[r] = 0.f; }
    float lsum = 0.f;
    f32x16 negm;
#pragma unroll
    for (int r = 0; r < 16; ++r) negm[r] = negb;
    __syncthreads();
    const size_t lrow0 = (size_t)MP + (size_t)b * SKEYS;
    const LAS char* wk = lds + S_W0 + r32 * S_WLD + 16 * hi;
    const LAS char* wv = lds + S_W0 + (64 + r32) * S_WLD + 16 * hi;
#define FENCE() asm volatile("" ::: "memory")
    for (int kb = wid; kb < (SKEYS + 31) / 32; kb += NWAVES) {
        const size_t row = lrow0 + (size_t)kb * 32 + r32;
        bf16x8 lf[8], rf[2];
#pragma unroll
        for (int s = 0; s < 8; ++s) lf[s] = *(const bf16x8*)(LAT + row * KVL + 16 * s + 8 * hi);
#pragma unroll
        for (int s = 0; s < 2; ++s) rf[s] = *(const bf16x8*)(KR + row * ROPE + 16 * s + 8 * hi);
        f32x16 kt0 = (f32x16){0.f, 0.f, 0.f, 0.f, 0.f, 0.f, 0.f, 0.f, 0.f, 0.f, 0.f, 0.f, 0.f, 0.f, 0.f, 0.f}, kt1 = kt0;
        { bf16x8 wq0[3], wq1[3];
          wq0[0] = *(const LAS bf16x8*)(wk); wq1[0] = *(const LAS bf16x8*)(wk + 32 * S_WLD); wq0[1] = *(const LAS bf16x8*)(wk + 32); wq1[1] = *(const LAS bf16x8*)(wk + 32 * S_WLD + 32);
#pragma unroll
          for (int s = 0; s < 8; ++s) {
            if (s + 2 < 8) { wq0[(s + 2) % 3] = *(const LAS bf16x8*)(wk + (s + 2) * 32); wq1[(s + 2) % 3] = *(const LAS bf16x8*)(wk + 32 * S_WLD + (s + 2) * 32); }
            kt0 = MFMA32(wq0[s % 3], lf[s], kt0); kt1 = MFMA32(wq1[s % 3], lf[s], kt1);
            FENCE(); } }
        float ss = 0.f;
#pragma unroll
        for (int r = 0; r < 16; ++r) ss += kt0[r] * kt0[r] + kt1[r] * kt1[r];
        ss = xsum32(ss);
        const float rk = __builtin_amdgcn_rsqf(ss * (1.0f / 64.0f) + EPS);
        bf16x8 kf[4];
#pragma unroll
        for (int s = 0; s < 4; ++s) { u32x4 w;
#pragma unroll
            for (int e = 0; e < 4; ++e) { const int r = 8 * (s & 1) + 2 * e; w[e] = (s < 2) ? cvtpk(kt0[r] * rk, kt0[r + 1] * rk) : cvtpk(kt1[r] * rk, kt1[r + 1] * rk); }
            kf[s] = __builtin_bit_cast(bf16x8, w); }
        f32x16 p = negm;
#pragma unroll
        for (int s = 0; s < 4; ++s) p = MFMA32(kf[s], qn[s], p);
        p = MFMA32(rf[0], qr[0], p); p = MFMA32(rf[1], qr[1], p);
        const bool full = (kb * 32 + 32) <= SKEYS;
        float sacc = 0.f;
#pragma unroll
        for (int r = 0; r < 16; ++r) { float e = __builtin_amdgcn_exp2f(p[r]); if (!full && (kb * 32 + crow(r, hi)) >= SKEYS) e = 0.f; p[r] = e; sacc += e; }
        lsum += sacc;
        bf16x8 pf[2];
#pragma unroll
        for (int s2 = 0; s2 < 2; ++s2) { u32x4 pw;
#pragma unroll
            for (int e = 0; e < 4; ++e) { const int r = 8 * s2 + 2 * e; pw[e] = cvtpk(p[r], p[r + 1]); }
            pf[s2] = __builtin_bit_cast(bf16x8, pw); }
        FENCE();
        f32x16 v0 = (f32x16){0.f, 0.f, 0.f, 0.f, 0.f, 0.f, 0.f, 0.f, 0.f, 0.f, 0.f, 0.f, 0.f, 0.f, 0.f, 0.f}, v1 = v0;
        { bf16x8 wq0[3], wq1[3];
          wq0[0] = *(const LAS bf16x8*)(wv); wq1[0] = *(const LAS bf16x8*)(wv + 32 * S_WLD); wq0[1] = *(const LAS bf16x8*)(wv + 32); wq1[1] = *(const LAS bf16x8*)(wv + 32 * S_WLD + 32);
#pragma unroll
          for (int s = 0; s < 8; ++s) {
            if (s + 2 < 8) { wq0[(s + 2) % 3] = *(const LAS bf16x8*)(wv + (s + 2) * 32); wq1[(s + 2) % 3] = *(const LAS bf16x8*)(wv + 32 * S_WLD + (s + 2) * 32); }
            v0 = MFMA32(lf[s], wq0[s % 3], v0); v1 = MFMA32(lf[s], wq1[s % 3], v1);
            FENCE(); } }
#pragma unroll
        for (int s2 = 0; s2 < 2; ++s2) { u32x4 vw0, vw1;
#pragma unroll
            for (int e = 0; e < 4; ++e) { const int r = 8 * s2 + 2 * e; vw0[e] = cvtpk(v0[r], v0[r + 1]); vw1[e] = cvtpk(v1[r], v1[r + 1]); }
            o0 = MFMA32(pf[s2], __builtin_bit_cast(bf16x8, vw0), o0); o1 = MFMA32(pf[s2], __builtin_bit_cast(bf16x8, vw1), o1); }
        FENCE();
    }
    lsum += __shfl_xor(lsum, 32);
    LAS float* ob = (LAS float*)(lds + S_OBUF) + wid * 2048; LAS float* lb = (LAS float*)(lds + S_LBUF) + wid * 32;
    if (hi == 0) lb[r32] = lsum;
#pragma unroll
    for (int r = 0; r < 16; ++r) { const int q = crow(r, hi); ob[q * 64 + r32] = o0[r]; ob[q * 64 + 32 + r32] = o1[r]; }
    __syncthreads();
    if (tid < 256) { const int q = tid >> 3, c8 = (tid & 7) * 8; float o[8], l = 0.f;
#pragma unroll
        for (int i = 0; i < 8; ++i) o[i] = 0.f;
#pragma unroll
        for (int w = 0; w < 8; ++w) { const LAS float* p = (const LAS float*)(lds + S_OBUF) + w * 2048 + q * 64 + c8; const f32x4 a = *(const LAS f32x4*)p, c = *(const LAS f32x4*)(p + 4);
            o[0] += a[0]; o[1] += a[1]; o[2] += a[2]; o[3] += a[3]; o[4] += c[0]; o[5] += c[1]; o[6] += c[2]; o[7] += c[3]; l += ((const LAS float*)(lds + S_LBUF))[w * 32 + q]; }
        const float rl = 1.0f / l;
#pragma unroll
        for (int i = 0; i < 8; ++i) o[i] *= rl;
        merge_store8((const bf16_t*)(F.ws + WS_GATES), (bf16_t*)(F.ws + WS_MIX), (size_t)MP + b * ST + q, h * 64 + c8, o); }
    __syncthreads();
}

DI void p7_attention(Frame& F) {
    const float negb = attn_negb(F);
#ifndef NO_SAMPLE
    for (int u0 = F.bid; u0 < SB * NH; u0 += F.G) { const int u = (F.G == 256) ? (u0 & 7) * 32 + (u0 >> 3) : u0; attn_sample_unit(F, u >> 4, u & 15, negb); }
#endif
#ifndef NO_PROMPT
    if (F.G == 256 && negb > -96.0f) {
        const int g = F.bid >> 6, bh = F.bid & 63;
        attn_prompt_unit64(F, bh >> 4, bh & 15, 7 - g); attn_prompt_unit64(F, bh >> 4, bh & 15, g);
    } else {
        for (int L = F.bid; L < PB * NH * 16; L += F.G) attn_prompt_unit(F, (L & 63) >> 4, L & 15, 15 - (L >> 6), negb);
    }
#endif
}


#define XB_TMO      128
#define XB_XCNT(j)  (256  + 64 * (j))
#define XB_XSUB(j)  (1280 + 64 * (j))
#define XB_XGEN(j)  (2304 + 64 * (j))
#define XB_TOP      3328
#define XB_TOPGEN   3392
#define XCD_BAR_WORDS 3456
#define XB_SPIN_CAP (1u << 22)
DI unsigned xb_ld(unsigned* p)              { return __hip_atomic_load(p, __ATOMIC_RELAXED, __HIP_MEMORY_SCOPE_AGENT); }
DI unsigned xb_add(unsigned* p, unsigned v) { return __hip_atomic_fetch_add(p, v, __ATOMIC_RELAXED, __HIP_MEMORY_SCOPE_AGENT); }
DI unsigned xb_xcc_id() { return (unsigned)__builtin_amdgcn_s_getreg((3 << 11) | 20) & 0xFu; }
#define XB_SPIN(cond, bar) do { unsigned _sp = 0; while (cond) { __builtin_amdgcn_s_sleep(1); \
    if ((++_sp & 255u) == 0u) { if (xb_ld(&(bar)[XB_TMO])) break; if (_sp > XB_SPIN_CAP) { atomicAdd(&(bar)[XB_TMO], 1u); break; } } } } while (0)
struct XcdBarrier { unsigned* bar; unsigned x; volatile LAS unsigned* st; };
DI XcdBarrier xcd_barrier_post(unsigned* bar, volatile LAS unsigned* st, bool leader) {
    XcdBarrier b; b.bar = bar; b.x = xb_xcc_id(); b.st = st;
    if (leader) (void)xb_add(&bar[XB_XCNT(b.x)], 1u);
    return b;
}
DI void xcd_barrier_complete(unsigned* bar, unsigned x, unsigned G, unsigned& nloc, unsigned& nx) {
    unsigned sum, cnt, mine, sp = 0u;
    for (;;) {
        sum = 0u; cnt = 0u; mine = 0u;
#pragma unroll
        for (unsigned j = 0; j < 16; ++j) { const unsigned c = xb_ld(&bar[XB_XCNT(j)]); sum += c; cnt += (c > 0u) ? 1u : 0u; mine = (j == x) ? c : mine; }
        if (sum == G) break;
        __builtin_amdgcn_s_sleep(1);
        if ((++sp & 255u) == 0u) { if (xb_ld(&bar[XB_TMO])) break; if (sp > XB_SPIN_CAP) { atomicAdd(&bar[XB_TMO], 1u); break; } }
    }
    nloc = mine > 0u ? mine : 1u; nx = cnt > 0u ? cnt : 1u;
}
DI void xcd_barrier(const XcdBarrier& b, unsigned G, int wave) {
    asm volatile("s_waitcnt vmcnt(0)" ::: "memory");
    __syncthreads();
    if (wave == 0 && fresh_lane() == 0) {
        unsigned* bar = b.bar;
        __builtin_amdgcn_s_waitcnt(0);
        unsigned nloc = b.st[0], nx = b.st[1];
        if (nloc == 0u) { xcd_barrier_complete(bar, b.x, G, nloc, nx); b.st[0] = nloc; b.st[1] = nx; }
        const unsigned old = xb_add(&bar[XB_XSUB(b.x)], 1u);
        const unsigned gen = old / nloc;
        if (old + 1u == (gen + 1u) * nloc) {
            __builtin_amdgcn_fence(__ATOMIC_RELEASE, "agent");
            asm volatile("s_waitcnt vmcnt(0)" ::: "memory");
            const unsigned og = xb_add(&bar[XB_TOP], 1u);
            const unsigned tg = og / nx;
            if (og + 1u == (tg + 1u) * nx) xb_add(&bar[XB_TOPGEN], 1u);
            else XB_SPIN(xb_ld(&bar[XB_TOPGEN]) == tg, bar);
            __builtin_amdgcn_fence(__ATOMIC_ACQUIRE, "agent");
            xb_add(&bar[XB_XGEN(b.x)], 1u);
            asm volatile("s_waitcnt vmcnt(0)" ::: "memory");
        } else {
            XB_SPIN(xb_ld(&bar[XB_XGEN(b.x)]) == gen, bar);
            __builtin_amdgcn_fence(__ATOMIC_ACQUIRE, "agent");
            asm volatile("s_waitcnt vmcnt(0)" ::: "memory");
        }
    }
    __syncthreads();
}

__global__ void __launch_bounds__(NTHREADS, 2) hybrid_fwd(Args args) {
    extern __shared__ __attribute__((aligned(16))) unsigned char lds_raw[];
    Frame F;
    F.lds = (LAS unsigned char*)lds_raw; F.wave = __builtin_amdgcn_readfirstlane(threadIdx.x >> 6);
    F.G = gridDim.x; F.bid = blockIdx.x; F.ws = args.ws; F.out = args.out;
    unsigned char* ws = args.ws;
    if (threadIdx.x < 30) ((LAS unsigned long long*)(F.lds + RING_BYTES))[threadIdx.x] = (unsigned long long)args.in[threadIdx.x];
    __syncthreads();
    const int lo = args.ph_lo, hi = args.ph_hi;
    if (threadIdx.x < 8) ((LAS unsigned*)(F.lds + RING_BYTES + 256))[threadIdx.x] = 0u;
    __syncthreads();
    const XcdBarrier bar = xcd_barrier_post((unsigned*)(ws + WS_CTL) + 1024, (volatile LAS unsigned*)(F.lds + RING_BYTES + 256), threadIdx.x == 0);
#ifndef PH_MASK
#define PH_MASK 0xFFFF
#endif
#define IN(k) (((PH_MASK >> (k)) & 1) && lo <= (k) && (k) < hi)
#define SEAM(k) do { if (IN(k) && IN((k) + 1)) xcd_barrier(bar, (unsigned)gridDim.x, F.wave); } while (0)
    const int bid = (int)blockIdx.x, G = (int)gridDim.x;

    if (IN(0)) { p0_prologue(F); } SEAM(0);
    if (IN(1)) {
        pg8::Gemm g{(const bf16_t*)(ws + WS_XN), (const bf16_t*)(ws + WS_WIN), 1024, 1024, 1024, 0, 1, 0, MT / 256, 14};
        pg8::StaticOrder S; S.init(g.nM, g.nN, G, bid);
        EpiIn E{(bf16_t*)(ws + WS_CQN), (float*)(ws + WS_SSCQ), (bf16_t*)(args.out + O_Y), (bf16_t*)(ws + WS_GATES), F.in(11), F.in(16), (const f32x2*)(ws + WS_TAB), args.out, (bf16_t*)(ws + WS_LAT), (bf16_t*)(ws + WS_KR)};
        pg8::gemm_phase<0>(F.lds, F.wave, g, S, E);
        { const int first = (g.nM * g.nN) % G;
          if (first != 0 && bid >= first) { late_weights(F, (bid - first) * NWAVES + F.wave, (G - first) * NWAVES, 0, G == 256 ? LATE_DOWN0 : LATE_ITEMS);
              if (G == 256) cache_convert(F, (bid - first) * NTHREADS + F.wave * 64 + fresh_lane(), (G - first) * NTHREADS, CACHE_P0, SB - CACHE_LATE); }
          else if (first == 0) late_weights(F, bid * NWAVES + F.wave, G * NWAVES, 0, LATE_ITEMS); }
    } SEAM(1);
    if (IN(2)) {
        pg8::Gemm g{(const bf16_t*)(ws + WS_UC), (const bf16_t*)(ws + WS_WLRU), 1024, 128, 128, 128, 1, 0, MP / 256, 8};
        pg8::StaticOrder S; S.init(g.nM, g.nN, G, bid);
        EpiLru E{(const bf16_t*)(ws + WS_UC), F.in(20), F.in(22), (const float*)(ws + WS_SP8), (bf16_t*)(ws + WS_LA), (bf16_t*)(ws + WS_BT)};
        conv_own_units(F, S);
        pg8::gemm_phase<0>(F.lds, F.wave, g, S, E);
        scan_local_own(F, S);
        lru_small(F);
    } SEAM(2);
    if (IN(3)) {
        p5_scan_apply(F);
        { pg8::Gemm g{(const bf16_t*)(ws + WS_CQN), (const bf16_t*)(ws + WS_WQB), 256, 256, 256, 0, 1, 0, MT / 256, 6};
          pg8::StaticOrder S; S.init(g.nM, g.nN, G, bid);
          EpiQ E{ws, F.in(13), F.in(14), (const f32x2*)(ws + WS_TAB), (const float*)(ws + WS_SSCQ)};
          pg8::gemm_phase<0>(F.lds, F.wave, g, S, E); }
        { pg8::Gemm g{(const bf16_t*)(ws + WS_LAT), (const bf16_t*)(ws + WS_WKVB), 128, 128, 128, 0, 1, 0, MP / 256, 8};
          pg8::StaticOrder S; S.init(g.nM, g.nN, G, (bid + 144) % G);
          EpiKV E{(bf16_t*)(args.out + O_Y), (bf16_t*)(args.out + O_Y) + (size_t)MP * DM, F.in(15)};
          pg8::gemm_phase<0>(F.lds, F.wave, g, S, E); }
        if (G == 256 && bid >= SCAN_EXTRA0 + 16) { constexpr int LIGHT0 = SCAN_EXTRA0 + 16; cache_convert(F, (bid - LIGHT0) * NTHREADS + F.wave * 64 + fresh_lane(), (256 - LIGHT0) * NTHREADS, SB - CACHE_LATE, SB); }
    } SEAM(3);
    if (IN(4)) { p7_attention(F); } SEAM(4);
    if (IN(5)) {
        { pg8::Gemm g{(const bf16_t*)(ws + WS_MIX), (const bf16_t*)(ws + WS_WOUT), 1024, 1024, 1024, 0, 1, 0, MP / 256, 4};
          pg8::StaticOrder S; S.init(g.nM, g.nN, G, bid);
          EpiOut E{F.in(0), (bf16_t*)(ws + WS_XMB), (float*)(ws + WS_SSROW)};
          pg8::gemm_phase<0>(F.lds, F.wave, g, S, E); }
        { FinOut fin{F.in(1), (bf16_t*)(ws + WS_XMB), (float*)(ws + WS_SSROW)};
          small_gemm<DM / 128>(F, (const bf16_t*)(ws + WS_MIX) + (size_t)MP * DM, DM, (const bf16_t*)(ws + WS_WOUT), DM, fin); }
    } SEAM(5);
    if (IN(6)) {
        static_assert(EpiUp<true>::N_FAST + EpiUp<true>::N_SLOW == (MT + 247) / 248, "row tiles of the up projection");
        { pg8::Gemm g{(const bf16_t*)(ws + WS_XMB) + 2 * DM, (const bf16_t*)(ws + WS_WUP), 1024, 1024, 1024, 0, 1, 0, EpiUp<true>::N_FAST, 22};
          pg8::StaticOrder S; S.init(g.nM, g.nN, G, bid);
          EpiUp<true> E{(const float*)(ws + WS_SSROW), (const float*)(ws + WS_CWS), F.in(6), (bf16_t*)(ws + WS_HFF), args.out + O_PFFN, args.out + O_SFFN};
          pg8::gemm_phase<2>(F.lds, F.wave, g, S, E); }
        { pg8::Gemm g{(const bf16_t*)(ws + WS_XMB) + 2 * DM, (const bf16_t*)(ws + WS_WUP), 1024, 1024, 1024, 0, 1, 0, EpiUp<false>::N_SLOW, 22};
          const int first = (EpiUp<true>::N_FAST * 22) % G;
          pg8::StaticOrder S; S.init(g.nM, g.nN, G, (bid - first + G) % G);
          EpiUp<false> E{(const float*)(ws + WS_SSROW), (const float*)(ws + WS_CWS), F.in(6), (bf16_t*)(ws + WS_HFF), args.out + O_PFFN, args.out + O_SFFN};
          pg8::gemm_phase<2>(F.lds, F.wave, g, S, E);
          constexpr int NSLOW = EpiUp<false>::N_SLOW * 22;
          if (G == 256) { const int c = (bid - first + G) % G; if (c >= NSLOW && bid >= first) late_weights(F, (c - NSLOW) * NWAVES + F.wave, (G - first - NSLOW) * NWAVES, LATE_DOWN0, LATE_ITEMS); } }
    } SEAM(6);
    if (IN(7)) {
        { pg8::Gemm g{(const bf16_t*)(ws + WS_HFF), (const bf16_t*)(ws + WS_WDOWN), DFF, DFF, DFF, 0, 1, 0, MP / 256, 4};
          pg8::StaticOrder S; S.init(g.nM, g.nN, G, bid);
          EpiDown E{(const bf16_t*)(ws + WS_XMB), args.out + O_Y};
          pg8::gemm_phase<0>(F.lds, F.wave, g, S, E); }
        { FinDown fin{(const bf16_t*)(ws + WS_XMB), args.out + O_Y};
          small_gemm<DFF / 128>(F, (const bf16_t*)(ws + WS_HFF) + (size_t)MP * DFF, DFF, (const bf16_t*)(ws + WS_WDOWN), DFF, fin); }
    }
#undef IN
#undef SEAM
}

extern "C" void kernel_launch(void* const* d_in, const int* in_sizes, int n_in, void* d_out, int out_size, void* d_ws, size_t ws_size, hipStream_t stream) {
    static int grid = 0;
    if (grid == 0) {
        if (n_in != 30 || out_size != (int)O_END || ws_size < WS_END) { fprintf(stderr, "kernel_launch: unexpected problem (n_in %d out %d ws %zu)\n", n_in, out_size, ws_size); grid = -1; return; }
        int dev = 0, cus = 0, per_cu = 0;
        hipGetDevice(&dev); hipDeviceGetAttribute(&cus, hipDeviceAttributeMultiprocessorCount, dev);
        if (hipFuncSetAttribute((const void*)hybrid_fwd, hipFuncAttributeMaxDynamicSharedMemorySize, LDS_BYTES) != hipSuccess) { fprintf(stderr, "kernel_launch: hipFuncSetAttribute failed\n"); grid = -1; return; }
        if (hipOccupancyMaxActiveBlocksPerMultiprocessor(&per_cu, (const void*)hybrid_fwd, NTHREADS, LDS_BYTES) != hipSuccess || per_cu < 1) { fprintf(stderr, "kernel_launch: occupancy query says %d\n", per_cu); per_cu = 1; }
        (void)hipGetLastError();
        grid = cus;
    }
    if (grid < 0) return;
    if (hipMemsetAsync((char*)d_ws + WS_CTL, 0, CTL_BYTES, stream) != hipSuccess) { fprintf(stderr, "kernel_launch: memset failed\n"); return; }
    Args a{};
    for (int i = 0; i < 30; ++i) a.in[i] = (const float*)d_in[i];
    a.out = (float*)d_out; a.ws = (unsigned char*)d_ws;
#if MK_LAUNCHES == 1
    a.ph_lo = 0; a.ph_hi = N_PHASES;
    void* kargs[] = {&a};
    hipError_t e = hipLaunchCooperativeKernel((const void*)hybrid_fwd, dim3(grid), dim3(NTHREADS), kargs, LDS_BYTES, stream);
    if (e != hipSuccess) fprintf(stderr, "kernel_launch: cooperative launch failed: %s (grid %d)\n", hipGetErrorString(e), grid);
#else
    for (int p = 0; p < N_PHASES; ++p) { a.ph_lo = p; a.ph_hi = p + 1; hipLaunchKernelGGL(hybrid_fwd, dim3(grid), dim3(NTHREADS), LDS_BYTES, stream, a); }
#endif
}
```
